# Optimizing an MI355X kernel written in HIP

```python
import math
import jax, jax.numpy as jnp
from jax import lax
import numpy as np

D_MODEL = 1024
BATCH = 4
SEQ = 4096
DEPTH = 4

CTX_LEN = 256
GRID_W = 64
HG_WIDTH = D_MODEL // 2
HG_DIM = 128
HG_HEADS = HG_WIDTH // HG_DIM
CHUNK = 64
DA_WIDTH = D_MODEL // 4
DA_HEADS = 4
DA_V = DA_WIDTH // DA_HEADS
DA_QK = DA_V // 2
DA_QK_WIDTH = DA_HEADS * 2 * DA_QK
Q_BLOCK = 128
ROPE_THETA = 10000.0
ROPE_AXIS_DIM = DA_QK // 2
FT_WIDTH = D_MODEL // 4
FT_GROUPS = 4
MIX_WIDTH = HG_WIDTH + DA_WIDTH + FT_WIDTH
IN_SPLITS = (HG_WIDTH, HG_WIDTH, HG_WIDTH, HG_WIDTH, HG_WIDTH, DA_QK_WIDTH, DA_QK_WIDTH, DA_WIDTH, FT_WIDTH)
IN_WIDTH = sum(IN_SPLITS)
FF_HIDDEN = ((8 * D_MODEL // 3 + 255) // 256) * 256
N_MOD = 6
EPS = 1e-6

kernel_name = "hymba_style_hgrn2_diffattn_fnet_dit"


def rms_norm(x, g):
    xf = x.astype(jnp.float32)
    y = xf * lax.rsqrt(jnp.mean(xf * xf, axis=-1, keepdims=True) + EPS)
    return (y * g.astype(jnp.float32)).astype(x.dtype)


def adaln(x, g, shift, scale):
    return rms_norm(x, g) * (1 + scale) + shift


def modulation(cond, w, b):
    return jnp.split(jax.nn.silu(cond) @ w + b, N_MOD, axis=-1)


def split_heads(a, h):
    return a.reshape(a.shape[:-1] + (h, a.shape[-1] // h))


def split_projection(p):
    offsets = [int(o) for o in np.cumsum(IN_SPLITS)[:-1]]
    return jnp.split(p, offsets, axis=-1)


def axial_rope(t_len):
    n_rows = t_len // GRID_W
    rows = jnp.broadcast_to(jnp.arange(n_rows)[:, None], (n_rows, GRID_W)).reshape(-1)
    cols = jnp.broadcast_to(jnp.arange(GRID_W)[None, :], (n_rows, GRID_W)).reshape(-1)
    inv_freq = 1.0 / (ROPE_THETA ** (jnp.arange(0, ROPE_AXIS_DIM, 2, dtype=jnp.float32) / ROPE_AXIS_DIM))
    ang = jnp.stack([rows, cols], axis=-1).astype(jnp.float32)[:, :, None] * inv_freq
    return jnp.cos(ang), jnp.sin(ang)


def apply_rope(x, cos, sin):
    xs = x.reshape(x.shape[:-1] + (2, 2, ROPE_AXIS_DIM // 2)).astype(jnp.float32)
    cs, sn = cos[None, :, None, None], sin[None, :, None, None]
    x1, x2 = xs[..., 0, :], xs[..., 1, :]
    out = jnp.stack([x1 * cs - x2 * sn, x2 * cs + x1 * sn], axis=-2)
    return out.reshape(x.shape).astype(x.dtype)


def gla_chunkwise(q, k, v, log_f, s0):
    b_, t_, h_, _ = q.shape
    dv = v.shape[-1]
    n = t_ // CHUNK

    def chunks(a):
        return a.astype(jnp.float32).reshape(b_, n, CHUNK, h_, a.shape[-1]).transpose(1, 0, 3, 2, 4)

    incl = jnp.tril(jnp.ones((CHUNK, CHUNK), dtype=bool))[:, :, None]

    def step(state, inp):
        qi, ki, vi, gi = inp
        bcum = jnp.cumsum(gi, axis=2)
        o_inter = jnp.einsum('bhtk,bhkv->bhtv', qi * jnp.exp(bcum), state)
        rel = bcum[:, :, :, None, :] - bcum[:, :, None, :, :]
        decay = jnp.exp(jnp.where(incl, rel, -jnp.inf))
        scores = jnp.einsum('bhtk,bhsk,bhtsk->bhts', qi, ki, decay)
        o_intra = jnp.einsum('bhts,bhsv->bhtv', scores, vi)
        blast = bcum[:, :, -1:, :]
        state = state * jnp.exp(blast[:, :, 0, :, None]) + jnp.einsum(
            'bhsk,bhsv->bhkv', ki * jnp.exp(blast - bcum), vi)
        return state, o_inter + o_intra

    s_fin, o = lax.scan(step, s0, (chunks(q), chunks(k), chunks(v), chunks(log_f)))
    return o.transpose(1, 0, 3, 2, 4).reshape(b_, t_, h_, dv), s_fin


def hgrn2_scan(q, v, z, lb, s0, reverse):
    f = lb + (1.0 - lb) * jax.nn.sigmoid(z.astype(jnp.float32))
    k = split_heads(1.0 - f, HG_HEADS)
    log_f = split_heads(jnp.log(f), HG_HEADS)
    if reverse:
        q, k, v, log_f = jnp.flip(q, 1), jnp.flip(k, 1), jnp.flip(v, 1), jnp.flip(log_f, 1)
    o, s = gla_chunkwise(q, k, v, log_f, s0)
    if reverse:
        o = jnp.flip(o, 1)
    return o, s


def diff_softmax_attend(q, keys, vals, lam):
    s = jnp.einsum('bqhmd,bkhmd->bhmqk', q, keys).astype(jnp.float32) * (DA_QK ** -0.5)
    p = jax.nn.softmax(s, axis=-1)
    w = p[:, :, 0] - lam * p[:, :, 1]
    return jnp.einsum('bhqk,bkhv->bqhv', w.astype(vals.dtype), vals)


def fourier_mix(u):
    uh = split_heads(u, FT_GROUPS).astype(jnp.float32)
    y = jnp.fft.fft2(uh, axes=(1, 3), norm="ortho").real
    return y.reshape(u.shape).astype(u.dtype)


def mixer(hl, hc, w_in, w_out, lb_f, lb_b, hg_onorm, da_lam, da_subln, lam_init, cos, sin, with_ctx):
    pl = split_projection(hl @ w_in)
    pc = split_projection(hc @ w_in)
    bsz, t_lat = hl.shape[0], hl.shape[1]

    s0 = jnp.zeros((bsz, HG_HEADS, HG_DIM, HG_DIM), jnp.float32)
    q_c, v_c = split_heads(jax.nn.silu(pc[0]), HG_HEADS), split_heads(pc[1], HG_HEADS)
    q_l, v_l = split_heads(jax.nn.silu(pl[0]), HG_HEADS), split_heads(pl[1], HG_HEADS)
    oc_f, st_f = hgrn2_scan(q_c, v_c, pc[3], lb_f, s0, False)
    oc_b, st_b = hgrn2_scan(q_c, v_c, pc[4], lb_b, s0, True)
    ol_f, _ = hgrn2_scan(q_l, v_l, pl[3], lb_f, st_f, False)
    ol_b, _ = hgrn2_scan(q_l, v_l, pl[4], lb_b, st_b, True)

    def hgrn_out(o, g):
        return (rms_norm(o, hg_onorm).reshape(g.shape) * jax.nn.silu(g)).astype(g.dtype)

    def qk_heads(a):
        return a.reshape(a.shape[:-1] + (DA_HEADS, 2, DA_QK))

    lam_f = da_lam.astype(jnp.float32)
    lam = jnp.exp(jnp.sum(lam_f[0] * lam_f[1])) - jnp.exp(jnp.sum(lam_f[2] * lam_f[3])) + lam_init
    dq_l, dk_l = apply_rope(qk_heads(pl[5]), cos, sin), apply_rope(qk_heads(pl[6]), cos, sin)
    dv_l = split_heads(pl[7], DA_HEADS)
    dq_c, dk_c, dv_c = qk_heads(pc[5]), qk_heads(pc[6]), split_heads(pc[7], DA_HEADS)
    keys = jnp.concatenate([dk_l, dk_c], axis=1)
    vals = jnp.concatenate([dv_l, dv_c], axis=1)
    nb = t_lat // Q_BLOCK
    qb = dq_l.reshape((bsz, nb, Q_BLOCK) + dq_l.shape[2:]).transpose(1, 0, 2, 3, 4, 5)
    od_l = lax.map(lambda qq: diff_softmax_attend(qq, keys, vals, lam), qb)
    od_l = od_l.transpose(1, 0, 2, 3, 4).reshape(bsz, t_lat, DA_HEADS, DA_V)

    def diff_out(o):
        return (rms_norm(o, da_subln) * (1.0 - lam_init)).reshape(o.shape[:2] + (DA_WIDTH,))

    yl = jnp.concatenate([hgrn_out(ol_f + ol_b, pl[2]), diff_out(od_l).astype(hl.dtype),
                          fourier_mix(pl[8])], axis=-1) @ w_out
    if not with_ctx:
        return yl, None
    od_c = diff_softmax_attend(dq_c, dk_c, dv_c, lam)
    yc = jnp.concatenate([hgrn_out(oc_f + oc_b, pc[2]), diff_out(od_c).astype(hc.dtype),
                          fourier_mix(pc[8])], axis=-1) @ w_out
    return yl, yc


def swiglu(h, w_i, w_o):
    g, u = jnp.split(h @ w_i, 2, axis=-1)
    return (jax.nn.silu(g) * u) @ w_o


def setup_inputs(seed: int = 0) -> dict:
    key = jax.random.key(seed)
    ks = jax.random.split(key, 15)
    f32 = jnp.float32
    nrm = lambda k, s: jax.random.normal(k, s, f32)
    return {
        "x": nrm(ks[0], (BATCH, SEQ, D_MODEL)),
        "c": nrm(ks[1], (BATCH, D_MODEL)),
        "ctx": nrm(ks[2], (BATCH, CTX_LEN, D_MODEL)),
        "c_ctx": nrm(ks[3], (D_MODEL,)),
        "w_mod": nrm(ks[4], (DEPTH, D_MODEL, N_MOD * D_MODEL)) * (0.5 * D_MODEL ** -0.5),
        "b_mod": nrm(ks[5], (DEPTH, N_MOD * D_MODEL)) * 0.01,
        "norm_g": 1.0 + 0.02 * nrm(ks[6], (DEPTH, 4, D_MODEL)),
        "w_in": nrm(ks[7], (DEPTH, D_MODEL, IN_WIDTH)) * D_MODEL ** -0.5,
        "w_out": nrm(ks[8], (DEPTH, MIX_WIDTH, D_MODEL)) * MIX_WIDTH ** -0.5,
        "hg_lb_logits": 0.1 * nrm(ks[9], (2, DEPTH, HG_WIDTH)),
        "hg_onorm": 1.0 + 0.02 * nrm(ks[10], (DEPTH, HG_DIM)),
        "da_lambda": 0.1 * nrm(ks[11], (DEPTH, 4, DA_QK)),
        "da_subln": 1.0 + 0.02 * nrm(ks[12], (DEPTH, DA_V)),
        "w_ffn_in": nrm(ks[13], (DEPTH, D_MODEL, 2 * FF_HIDDEN)) * D_MODEL ** -0.5,
        "w_ffn_out": nrm(ks[14], (DEPTH, FF_HIDDEN, D_MODEL)) * FF_HIDDEN ** -0.5,
    }


def reference(x, c, ctx, c_ctx, w_mod, b_mod, norm_g, w_in, w_out, hg_lb_logits, hg_onorm,
              da_lambda, da_subln, w_ffn_in, w_ffn_out):
    cos, sin = axial_rope(x.shape[1])
    lb_p = jax.nn.softmax(hg_lb_logits.astype(jnp.float32), axis=1)
    lower_bounds = jnp.cumsum(lb_p, axis=1) - lb_p[:, :1]
    xl, xc = x, ctx
    for l in range(DEPTH):
        with_ctx = l < DEPTH - 1
        lam_init = 0.8 - 0.6 * math.exp(-0.3 * l)
        ml = modulation(c[:, None, :], w_mod[l], b_mod[l])
        mc = modulation(c_ctx[None, None, :], w_mod[l], b_mod[l])
        g = norm_g[l]
        hl = adaln(xl, g[0], ml[0], ml[1])
        hc = adaln(xc, g[0], mc[0], mc[1])
        yl, yc = mixer(hl, hc, w_in[l], w_out[l], lower_bounds[0, l], lower_bounds[1, l], hg_onorm[l],
                       da_lambda[l], da_subln[l], lam_init, cos, sin, with_ctx)
        xl = xl + ml[2] * rms_norm(yl, g[1])
        xl = xl + ml[5] * rms_norm(swiglu(adaln(xl, g[2], ml[3], ml[4]), w_ffn_in[l], w_ffn_out[l]), g[3])
        if with_ctx:
            xc = xc + mc[2] * rms_norm(yc, g[1])
            xc = xc + mc[5] * rms_norm(swiglu(adaln(xc, g[2], mc[3], mc[4]), w_ffn_in[l], w_ffn_out[l]), g[3])
    return xl
```

```cpp
#include <hip/hip_runtime.h>
#include <hip/hip_cooperative_groups.h>
#include <cstdio>
#include <cstdint>
#include <cstring>
namespace cg = cooperative_groups;
__device__ __forceinline__ int opaque_tid() { int t = threadIdx.x; asm volatile("" : "+v"(t)); return t; }
namespace pg8 {
#define PG8_LAS __attribute__((address_space(3)))
typedef unsigned short bf16_t;
typedef short bf16x8 __attribute__((ext_vector_type(8)));
typedef float f32x4 __attribute__((ext_vector_type(4)));
typedef unsigned u32x4 __attribute__((ext_vector_type(4)));
constexpr int BM = 256, BK = 64, HALF = 128, HTB = HALF * BK * 2  , STAGE_BYTES = 8 * HTB, NXCD = 8, WGM = 8;

__host__ __device__ __forceinline__ int lds_byte(int r, int c) { const int st = (r >> 4) * 2 + (c >> 5), rr = r & 15, cc = c & 31, ob = rr * 64 + cc * 2; return st * 1024 + (ob ^ (((ob >> 9) & 1) << 5)); }
__host__ __device__ __forceinline__ void stage_rc(int b, int& R, int& C) { const int st = b / 1024, sb = b % 1024, swz = sb ^ (((sb >> 9) & 1) << 5); R = (st >> 1) * 16 + swz / 64; C = (st & 1) * 32 + (swz % 64) / 2; }
__host__ __device__ __forceinline__ int perm32(int rho) { const int n = rho >> 4, i = rho & 15; return 8 * (i >> 2) + 4 * n + (i & 3); }

struct Unit { int pm, pn; };
struct Gemm { const bf16_t* A; const bf16_t* Bt; int M, N, K; };

struct StaticOrder {
    int nM, nN, nwg, G, c;
    __host__ __device__ void init(int M, int N, int G_, int c_) { nM = M / BM; nN = N / BM; nwg = nM * nN; G = G_; c = c_; }
    __host__ __device__ bool next(int i, Unit& u) const {
        const long L = (long)i * G + c; if (L >= nwg) return false;
        int wgid = (int)L; { const int q = nwg / NXCD, r = nwg % NXCD, xcd = wgid % NXCD, off = wgid / NXCD; wgid = (xcd < r ? xcd * (q + 1) : r * (q + 1) + (xcd - r) * q) + off; }
        const int nig = WGM * nN, gid = wgid / nig, fm = gid * WGM, gsz = (nM - fm) < WGM ? (nM - fm) : WGM;
        u.pm = fm + ((wgid % nig) % gsz); u.pn = (wgid % nig) / gsz; return true;
    }
    __device__ __forceinline__ void a_ready(const Unit&) const {}
    __device__ __forceinline__ void done(const Unit&) const {}
};

__device__ __forceinline__ unsigned cvt_pk_bf16(float lo, float hi) { unsigned r; asm volatile("v_cvt_pk_bf16_f32 %0, %1, %2" : "=v"(r) : "v"(lo), "v"(hi)); return r; }
typedef float f32x2 __attribute__((ext_vector_type(2)));
template <class Epi, class Sched, bool ALIGN_EPI = false, bool SP2 = false>
__device__ __forceinline__ void gemm_phase(PG8_LAS unsigned char* lds, const Gemm g, const Sched& S, const Epi& E) {
    const int tid = opaque_tid(), wid = __builtin_amdgcn_readfirstlane(tid >> 6), lane = tid & 63, wr = wid >> 2, wc = wid & 3, fr = lane & 15, fq = lane >> 4;
    const int K = g.K, nt = K / BK;
    unsigned voffA[2], voffB[2];
#pragma unroll
    for (int i = 0; i < 2; ++i) { int R, C; stage_rc(tid * 16 + i * 8192, R, C); const int Rb = Epi::PERM ? ((R & ~31) + perm32(R & 31)) : R;
        voffA[i] = (unsigned)(R * K + C) * 2u; voffB[i] = (unsigned)(Rb * K + C) * 2u; }
    const size_t kstep = (size_t)(BK * 2);
    const size_t hstep = (size_t)HALF * K * 2;
    const size_t tstep = 2 * hstep;
    const unsigned ldsw = (unsigned)wid * 1024u;
    const int aoff = lds_byte(wr * 64 + fr, fq * 8), boff = lds_byte(wc * 32 + fr, fq * 8);
#define PG8_SA(b, h) (((b) * 2 + (h)) * HTB)
#define PG8_SB(b, h) ((4 + (b) * 2 + (h)) * HTB)
#define PG8_STAGE(bufoff, gbase, voff) do { _Pragma("unroll") for (int _i = 0; _i < 2; ++_i) \
        __builtin_amdgcn_global_load_lds((const unsigned*)((const char*)(gbase) + (voff)[_i]), (PG8_LAS unsigned*)(lds + (bufoff) + ldsw + _i * 8192), 16, 0, 0); } while (0)
#define PG8_LDA(dst, b, h) do { _Pragma("unroll") for (int m = 0; m < 4; ++m) _Pragma("unroll") for (int k = 0; k < 2; ++k) dst[m][k] = *(const PG8_LAS bf16x8*)(lds + PG8_SA(b, h) + aoff + m * 2048 + k * 1024); } while (0)
#define PG8_LDB(dst, b, h) do { _Pragma("unroll") for (int n = 0; n < 2; ++n) _Pragma("unroll") for (int k = 0; k < 2; ++k) dst[n][k] = *(const PG8_LAS bf16x8*)(lds + PG8_SB(b, h) + boff + n * 2048 + k * 1024); } while (0)
#define PG8_MMA(ai, bj, At, Bt) do { __builtin_amdgcn_s_setprio(1); _Pragma("unroll") for (int m = 0; m < 4; ++m) _Pragma("unroll") for (int n = 0; n < 2; ++n) _Pragma("unroll") for (int k = 0; k < 2; ++k) \
        acc[ai][bj][m][n] = __builtin_amdgcn_mfma_f32_16x16x32_bf16(Bt[n][k], At[m][k], acc[ai][bj][m][n], 0, 0, 0); __builtin_amdgcn_s_setprio(0); } while (0)
#define PG8_WAIT_V(n) asm volatile("s_waitcnt vmcnt(" #n ")" ::: "memory")
#define PG8_WAIT_L(n) asm volatile("s_waitcnt lgkmcnt(" #n ")" ::: "memory")
#define PG8_BAR __builtin_amdgcn_s_barrier()
#define PG8_SCHED __builtin_amdgcn_sched_barrier(0)
    Unit cur, nxt; int ui = 0;
    if (!S.next(0, cur)) return;
    f32x4 acc[2][2][4][2];
#pragma unroll
    for (int a = 0; a < 2; ++a)
#pragma unroll
        for (int b = 0; b < 2; ++b)
#pragma unroll
            for (int m = 0; m < 4; ++m)
#pragma unroll
                for (int n = 0; n < 2; ++n) acc[a][b][m][n] = (f32x4){0.f, 0.f, 0.f, 0.f};
    bf16x8 At[4][2], B0[2][2], B1[2][2];
    const char* cA = (const char*)g.A + (size_t)cur.pm * tstep; const char* cB = (const char*)g.Bt + (size_t)cur.pn * tstep;
    S.a_ready(cur);
    if constexpr (SP2) {
        PG8_STAGE(PG8_SB(0, 0), cB, voffB); PG8_STAGE(PG8_SB(0, 1), cB + hstep, voffB); PG8_STAGE(PG8_SA(0, 0), cA, voffA); PG8_STAGE(PG8_SA(0, 1), cA + hstep, voffA);
        if (wr == 1) PG8_BAR;
        PG8_WAIT_V(2); PG8_BAR;
        PG8_STAGE(PG8_SB(1, 0), cB + kstep, voffB); PG8_STAGE(PG8_SA(1, 0), cA + kstep, voffA); PG8_STAGE(PG8_SB(1, 1), cB + hstep + kstep, voffB);
        PG8_WAIT_V(6); PG8_BAR;
    } else {
        PG8_STAGE(PG8_SB(0, 0), cB, voffB); PG8_STAGE(PG8_SA(0, 0), cA, voffA); PG8_STAGE(PG8_SB(0, 1), cB + hstep, voffB); PG8_STAGE(PG8_SA(0, 1), cA + hstep, voffA);
        if (wr == 1) PG8_BAR;
        PG8_WAIT_V(4); PG8_BAR;
        PG8_STAGE(PG8_SB(1, 0), cB + kstep, voffB); PG8_STAGE(PG8_SA(1, 0), cA + kstep, voffA); PG8_STAGE(PG8_SB(1, 1), cB + hstep + kstep, voffB);
        PG8_WAIT_V(6); PG8_BAR;
    }
    for (;;) {
        const bool has_next = S.next(ui + 1, nxt);
        const char* nA = has_next ? (const char*)g.A + (size_t)nxt.pm * tstep : cA; const char* nB = has_next ? (const char*)g.Bt + (size_t)nxt.pn * tstep : cB;
        for (int t = 0; t < nt; t += 2) {
            const bool last = (t == nt - 2);
            const char* a1 = cA + (size_t)(t + 1) * kstep;
            const char* a2 = last ? nA : cA + (size_t)(t + 2) * kstep; const char* b2 = last ? nB : cB + (size_t)(t + 2) * kstep;
            const char* a3 = a2 + kstep; const char* b3 = b2 + kstep;
            if (last && has_next) S.a_ready(nxt);
            if constexpr (SP2) {
            PG8_LDB(B0, 0, 0); PG8_LDB(B1, 0, 1); PG8_SCHED; PG8_LDA(At, 0, 0); PG8_STAGE(PG8_SA(1, 1), a1 + hstep, voffA);
            PG8_WAIT_V(8); PG8_WAIT_L(0); PG8_BAR; PG8_MMA(0, 0, At, B0); PG8_MMA(0, 1, At, B1); PG8_BAR; PG8_SCHED;
            PG8_LDA(At, 0, 1); PG8_STAGE(PG8_SB(0, 0), b2, voffB); PG8_STAGE(PG8_SB(0, 1), b2 + hstep, voffB); PG8_STAGE(PG8_SA(0, 0), a2, voffA);
            PG8_WAIT_V(8); PG8_WAIT_L(0); PG8_BAR; PG8_MMA(1, 0, At, B0); PG8_MMA(1, 1, At, B1); PG8_BAR; PG8_SCHED;
            PG8_LDB(B0, 1, 0); PG8_LDB(B1, 1, 1); PG8_SCHED; PG8_LDA(At, 1, 0); PG8_STAGE(PG8_SA(0, 1), a2 + hstep, voffA);
            PG8_WAIT_V(8); PG8_WAIT_L(0); PG8_BAR; PG8_MMA(0, 0, At, B0); PG8_MMA(0, 1, At, B1); PG8_BAR; PG8_SCHED;
            PG8_LDA(At, 1, 1); PG8_STAGE(PG8_SB(1, 0), b3, voffB); PG8_STAGE(PG8_SB(1, 1), b3 + hstep, voffB); PG8_STAGE(PG8_SA(1, 0), a3, voffA);
            PG8_WAIT_V(8); PG8_WAIT_L(0); PG8_BAR; PG8_MMA(1, 0, At, B0); PG8_MMA(1, 1, At, B1); PG8_BAR; PG8_SCHED;
            } else {
            PG8_LDB(B0, 0, 0); PG8_SCHED; PG8_LDA(At, 0, 0); PG8_STAGE(PG8_SA(1, 1), a1 + hstep, voffA);
            PG8_WAIT_L(8); PG8_BAR; PG8_WAIT_L(0); PG8_MMA(0, 0, At, B0); PG8_BAR; PG8_SCHED;
            PG8_LDB(B1, 0, 1); PG8_STAGE(PG8_SB(0, 0), b2, voffB);
            PG8_BAR; PG8_WAIT_L(0); PG8_MMA(0, 1, At, B1); PG8_BAR;
            PG8_LDA(At, 0, 1); PG8_STAGE(PG8_SA(0, 0), a2, voffA);
            PG8_BAR; PG8_WAIT_L(0); PG8_MMA(1, 0, At, B0); PG8_BAR; PG8_SCHED;
            PG8_STAGE(PG8_SB(0, 1), b2 + hstep, voffB);
            PG8_WAIT_V(6); PG8_BAR; PG8_MMA(1, 1, At, B1); PG8_BAR;
            PG8_LDB(B0, 1, 0); PG8_SCHED; PG8_LDA(At, 1, 0); PG8_STAGE(PG8_SA(0, 1), a2 + hstep, voffA);
            PG8_WAIT_L(8); PG8_BAR; PG8_WAIT_L(0); PG8_MMA(0, 0, At, B0); PG8_BAR; PG8_SCHED;
            PG8_LDB(B1, 1, 1); PG8_STAGE(PG8_SB(1, 0), b3, voffB);
            PG8_BAR; PG8_WAIT_L(0); PG8_MMA(0, 1, At, B1); PG8_BAR;
            PG8_LDA(At, 1, 1); PG8_STAGE(PG8_SA(1, 0), a3, voffA);
            PG8_BAR; PG8_WAIT_L(0); PG8_MMA(1, 0, At, B0); PG8_BAR; PG8_SCHED;
            PG8_STAGE(PG8_SB(1, 1), b3 + hstep, voffB);
            PG8_WAIT_V(6); PG8_BAR; PG8_MMA(1, 1, At, B1); PG8_BAR;
            }
        }
        if constexpr (ALIGN_EPI) { if (wr == 0) PG8_BAR; }
        if constexpr (!Epi::AFTER_DRAIN) { E(acc, cur, wr, wc, fr, fq); S.done(cur); }
        if (!has_next) break;
#pragma unroll
        for (int a = 0; a < 2; ++a)
#pragma unroll
            for (int b = 0; b < 2; ++b)
#pragma unroll
                for (int m = 0; m < 4; ++m)
#pragma unroll
                    for (int n = 0; n < 2; ++n) acc[a][b][m][n] = (f32x4){0.f, 0.f, 0.f, 0.f};
        cur = nxt; cA = nA; cB = nB; ++ui;
        if constexpr (ALIGN_EPI) { if (wr == 1) PG8_BAR; }
    }
    PG8_WAIT_V(0);
    if constexpr (!ALIGN_EPI) { if (wr == 0) PG8_BAR; }
    PG8_BAR;
    if constexpr (Epi::AFTER_DRAIN) { E.fused(acc, cur, wr, wc, fr, fq, lds, wid, lane); S.done(cur); }
#undef PG8_SA
#undef PG8_SB
#undef PG8_STAGE
#undef PG8_LDA
#undef PG8_LDB
#undef PG8_MMA
#undef PG8_WAIT_V
#undef PG8_WAIT_L
#undef PG8_BAR
#undef PG8_SCHED
}
}

constexpr int DM = 1024, NB = 4, SEQ = 4096, CTX = 256, DEPTH = 4;
constexpr int ML = NB * SEQ, MC = NB * CTX, MR = ML + MC;
constexpr int KEYS = SEQ + CTX;
constexpr int INW = 3584, INW2 = 3840, FFH = 2816, NMOD = 6;
constexpr float EPS = 1e-6f;
constexpr float QSCALE = 0.17677669529663687f * 1.4426950408889634f;

constexpr size_t MiB = 1u << 20;
constexpr size_t WS_CTL = 0, CTL_ZERO_BYTES = 1 * MiB;
constexpr size_t WS_MOD = 1 * MiB;
constexpr size_t WS_TAB = 2 * MiB;
constexpr size_t TAB_ROPEC = 0, TAB_ROPES = 2048, TAB_LAM = 4096, TAB_LB = 8192;
constexpr size_t WS_FC = 3 * MiB;
constexpr size_t WS_XC = 4 * MiB;
constexpr size_t WS_WIN = 8 * MiB;
constexpr size_t WS_WOUT = 16 * MiB;
constexpr size_t WS_WFI = 18 * MiB;
constexpr size_t WS_WFO = 29 * MiB;
constexpr size_t WS_F = 36 * MiB;
constexpr size_t WS_H = 100 * MiB;
constexpr size_t WS_B = 134 * MiB;
constexpr size_t PSTRIDE = 17 * MiB;
constexpr size_t WS_PQ = WS_B;
constexpr size_t WS_AQ = WS_B + 85 * MiB;
constexpr size_t WS_AK = WS_AQ + 9 * MiB;
constexpr size_t WS_AV = WS_AK + 9 * MiB;
constexpr size_t WS_BTL = WS_AV + 9 * MiB;
constexpr size_t WS_BTC = WS_BTL + 16 * MiB;
constexpr size_t WS_OF = WS_BTC + 1 * MiB;
constexpr size_t WS_Y = WS_B;
constexpr size_t WS_ACT = WS_B + 68 * MiB;
constexpr size_t WS_END = WS_OF + 34 * MiB;
static_assert(WS_ACT + (size_t)MR * FFH * 2 <= 384 * MiB && WS_END <= 384 * MiB, "ws map");

constexpr int CW_BAR = 4096;

constexpr int RING_BYTES = 131072;
constexpr int LDSCTL_OFF = RING_BYTES, MISC_OFF = LDSCTL_OFF + 320;
constexpr int LDS_BYTES = 147456;
constexpr int NTHREADS = 512;

#define LAS __attribute__((address_space(3)))
typedef unsigned short bf16_t;
typedef float f32x4 __attribute__((ext_vector_type(4)));
typedef unsigned u32x4 __attribute__((ext_vector_type(4)));
typedef unsigned u32x2 __attribute__((ext_vector_type(2)));

__device__ __forceinline__ float bf2f(unsigned short b) { return __uint_as_float(((unsigned)b) << 16); }
__device__ __forceinline__ unsigned pk2(float lo, float hi) { return pg8::cvt_pk_bf16(lo, hi); }
__device__ __forceinline__ float silu_f(float x) { return x / (1.f + __expf(-x)); }
__device__ __forceinline__ float wave_sum(float v) {
#pragma unroll
    for (int o = 1; o < 64; o <<= 1) v += __shfl_xor(v, o);
    return v;
}

#define XB_TMO      128
#define XB_XCNT(j)  (256  + 64 * (j))
#define XB_XSUB(j)  (1280 + 64 * (j))
#define XB_XGEN(j)  (2304 + 64 * (j))
#define XB_TOP      3328
#define XB_TOPGEN   3392
#define XCD_BAR_WORDS 3456
#define XB_SPIN_CAP (1u << 22)
__device__ __forceinline__ unsigned xb_ld(unsigned* p)              { return __hip_atomic_load(p, __ATOMIC_RELAXED, __HIP_MEMORY_SCOPE_AGENT); }
__device__ __forceinline__ unsigned xb_add(unsigned* p, unsigned v) { return __hip_atomic_fetch_add(p, v, __ATOMIC_RELAXED, __HIP_MEMORY_SCOPE_AGENT); }
__device__ __forceinline__ unsigned xb_xcc_id() { return (unsigned)__builtin_amdgcn_s_getreg((3 << 11) | 20) & 0xFu; }
#define XB_SPIN(cond, bar) do { unsigned _sp = 0; while (cond) { __builtin_amdgcn_s_sleep(1); \
    if ((++_sp & 255u) == 0u) { if (xb_ld(&(bar)[XB_TMO])) break; if (_sp > XB_SPIN_CAP) { atomicAdd(&(bar)[XB_TMO], 1u); break; } } } } while (0)
struct XcdBarrier { unsigned* bar; unsigned x; volatile LAS unsigned* st; };
__device__ __forceinline__ XcdBarrier xcd_barrier_post(unsigned* bar, volatile LAS unsigned* st) {
    XcdBarrier b; b.bar = bar; b.x = xb_xcc_id(); b.st = st;
    if (threadIdx.x == 0) (void)xb_add(&bar[XB_XCNT(b.x)], 1u);
    return b;
}
__device__ __forceinline__ void xcd_barrier_complete(unsigned* bar, unsigned x, unsigned& nloc, unsigned& nx) {
    const unsigned G = gridDim.x * gridDim.y * gridDim.z;
    unsigned sum, cnt, mine, sp = 0u;
    for (;;) {
        sum = 0u; cnt = 0u; mine = 0u;
#pragma unroll
        for (unsigned j = 0; j < 16; ++j) { const unsigned c = xb_ld(&bar[XB_XCNT(j)]); sum += c; cnt += (c > 0u) ? 1u : 0u; mine = (j == x) ? c : mine; }
        if (sum == G) break;
        __builtin_amdgcn_s_sleep(1);
        if ((++sp & 255u) == 0u) { if (xb_ld(&bar[XB_TMO])) break; if (sp > XB_SPIN_CAP) { atomicAdd(&bar[XB_TMO], 1u); break; } }
    }
    nloc = mine > 0u ? mine : 1u; nx = cnt > 0u ? cnt : 1u;
}
__device__ __forceinline__ void xcd_barrier(const XcdBarrier& b) {
    asm volatile("s_waitcnt vmcnt(0)" ::: "memory");
    __syncthreads();
    if (threadIdx.x == 0) {
        unsigned* bar = b.bar;
        __builtin_amdgcn_s_waitcnt(0);
        unsigned nloc = b.st[0], nx = b.st[1];
        if (nloc == 0u) { xcd_barrier_complete(bar, b.x, nloc, nx); b.st[0] = nloc; b.st[1] = nx; }
        const unsigned old = xb_add(&bar[XB_XSUB(b.x)], 1u);
        const unsigned gen = old / nloc;
        if (old + 1u == (gen + 1u) * nloc) {
            __builtin_amdgcn_fence(__ATOMIC_RELEASE, "agent");
            asm volatile("s_waitcnt vmcnt(0)" ::: "memory");
            const unsigned og = xb_add(&bar[XB_TOP], 1u);
            const unsigned tg = og / nx;
            if (og + 1u == (tg + 1u) * nx) xb_add(&bar[XB_TOPGEN], 1u);
            else XB_SPIN(xb_ld(&bar[XB_TOPGEN]) == tg, bar);
            __builtin_amdgcn_fence(__ATOMIC_ACQUIRE, "agent");
            xb_add(&bar[XB_XGEN(b.x)], 1u);
            asm volatile("s_waitcnt vmcnt(0)" ::: "memory");
        } else {
            XB_SPIN(xb_ld(&bar[XB_XGEN(b.x)]) == gen, bar);
            __builtin_amdgcn_fence(__ATOMIC_ACQUIRE, "agent");
            asm volatile("s_waitcnt vmcnt(0)" ::: "memory");
        }
    }
    __syncthreads();
}

using pg8::Unit;
struct EpiInProj {
    static constexpr bool PERM = true, AFTER_DRAIN = false;
    unsigned char* ws; const float* lb;
    template <int KIND> __device__ __forceinline__ void hg_part(const f32x4 (&acc)[2][2][4][2], bf16_t* dst, const float* lbp, int rbase, int cb) const {
#pragma unroll
        for (int bj = 0; bj < 2; ++bj) {
            const int cc = cb + bj * 128;
            f32x4 l0 = {0.f, 0.f, 0.f, 0.f}, l1 = {0.f, 0.f, 0.f, 0.f};
            if (KIND == 2) { l0 = *(const f32x4*)(lbp + cc); l1 = *(const f32x4*)(lbp + cc + 4); }
#pragma unroll
            for (int ai = 0; ai < 2; ++ai)
#pragma unroll
                for (int m = 0; m < 4; ++m) {
                    f32x4 v0 = acc[ai][bj][m][0], v1 = acc[ai][bj][m][1];
                    if (KIND == 1) {
#pragma unroll
                        for (int e = 0; e < 4; ++e) { v0[e] = silu_f(v0[e]); v1[e] = silu_f(v1[e]); }
                    } else if (KIND == 2) {
#pragma unroll
                        for (int e = 0; e < 4; ++e) {
                            const float f0 = l0[e] + (1.f - l0[e]) / (1.f + __expf(-v0[e])); v0[e] = __logf(f0);
                            const float f1 = l1[e] + (1.f - l1[e]) / (1.f + __expf(-v1[e])); v1[e] = __logf(f1);
                        }
                    }
                    u32x4 w; w.x = pk2(v0[0], v0[1]); w.y = pk2(v0[2], v0[3]); w.z = pk2(v1[0], v1[1]); w.w = pk2(v1[2], v1[3]);
                    *(u32x4*)(dst + (size_t)(rbase + ai * 128 + m * 16) * 512 + cc) = w;
                }
        }
    }
    __device__ __forceinline__ void operator()(const f32x4 (&acc)[2][2][4][2], const Unit& u, int wr, int wc, int fr_, int fq_) const {
        int fr = fr_, fq = fq_; asm volatile("" : "+v"(fr), "+v"(fq));
        const int pn = u.pn;
        const int rbase = u.pm * 256 + wr * 64 + fr;
        const int cl = wc * 32 + 8 * fq;
        if (pn < 10) {
            const int kind = pn >> 1, cb = (pn & 1) * 256 + cl;
            bf16_t* dst = (bf16_t*)(ws + WS_PQ + (size_t)kind * PSTRIDE);
            if (kind == 0 || kind == 2) hg_part<1>(acc, dst, lb, rbase, cb);
            else if (kind == 1) hg_part<0>(acc, dst, lb, rbase, cb);
            else hg_part<2>(acc, dst, lb + (kind - 3) * 512, rbase, cb);
        } else if (pn <= 11) {
            const bool isq = (pn == 10);
            bf16_t* dst = (bf16_t*)(ws + (isq ? WS_AQ : WS_AK));
            const float sc = isq ? QSCALE : 1.f;
            const bool lat = u.pm < 64;
            const float sgn = (fq & 1) ? 1.f : -1.f;
            const float* rc = (const float*)(ws + WS_TAB + TAB_ROPEC);
            const float* rs = (const float*)(ws + WS_TAB + TAB_ROPES);
#pragma unroll
            for (int ai = 0; ai < 2; ++ai)
#pragma unroll
                for (int m = 0; m < 4; ++m) {
                    const int row = rbase + ai * 128 + m * 16;
                    size_t orow;
                    if (isq) orow = (size_t)row;
                    else orow = lat ? (size_t)((row >> 12) * KEYS + (row & 4095)) : (size_t)(((row - ML) >> 8) * KEYS + SEQ + ((row - ML) & 255));
                    f32x4 c0 = {1.f, 1.f, 1.f, 1.f}, c1 = c0, s0 = {0.f, 0.f, 0.f, 0.f}, s1 = s0;
                    if (lat) { const int t = row & 4095, pos = (fq < 2) ? (t >> 6) : (t & 63);
                        c0 = *(const f32x4*)(rc + pos * 8); c1 = *(const f32x4*)(rc + pos * 8 + 4); s0 = *(const f32x4*)(rs + pos * 8); s1 = *(const f32x4*)(rs + pos * 8 + 4); }
#pragma unroll
                    for (int bj = 0; bj < 2; ++bj) {
                        f32x4 v0 = acc[ai][bj][m][0], v1 = acc[ai][bj][m][1];
                        if (lat) {
                            f32x4 p0, p1;
#pragma unroll
                            for (int e = 0; e < 4; ++e) { p0[e] = __shfl_xor(v0[e], 16); p1[e] = __shfl_xor(v1[e], 16); }
                            v0 = v0 * c0 + (p0 * s0) * sgn; v1 = v1 * c1 + (p1 * s1) * sgn;
                        }
                        v0 = v0 * sc; v1 = v1 * sc;
                        u32x4 w; w.x = pk2(v0[0], v0[1]); w.y = pk2(v0[2], v0[3]); w.z = pk2(v1[0], v1[1]); w.w = pk2(v1[2], v1[3]);
                        *(u32x4*)(dst + orow * 256 + cl + bj * 128) = w;
                    }
                }
        } else if (pn == 12) {
            bf16_t* dst = (bf16_t*)(ws + WS_AV);
            const bool lat = u.pm < 64;
#pragma unroll
            for (int ai = 0; ai < 2; ++ai)
#pragma unroll
                for (int m = 0; m < 4; ++m) {
                    const int row = rbase + ai * 128 + m * 16;
                    const size_t orow = lat ? (size_t)((row >> 12) * KEYS + (row & 4095)) : (size_t)(((row - ML) >> 8) * KEYS + SEQ + ((row - ML) & 255));
#pragma unroll
                    for (int bj = 0; bj < 2; ++bj) {
                        const f32x4 v0 = acc[ai][bj][m][0], v1 = acc[ai][bj][m][1];
                        u32x4 w; w.x = pk2(v0[0], v0[1]); w.y = pk2(v0[2], v0[3]); w.z = pk2(v1[0], v1[1]); w.w = pk2(v1[2], v1[3]);
                        *(u32x4*)(dst + orow * 256 + cl + bj * 128) = w;
                    }
                }
        } else {
            const int is_s = pn - 13;
            const bool lat = u.pm < 64;
            const unsigned cs2 = lat ? 8192u * 2u : 512u * 2u;
            __amdgpu_buffer_rsrc_t rs = __builtin_amdgcn_make_buffer_rsrc((void*)(ws + (lat ? WS_BTL : WS_BTC)), 0, lat ? (int)(NB * 256 * 8192 * 2) : (int)(NB * 256 * 512 * 2), 0x00020000);
#pragma unroll
            for (int ai = 0; ai < 2; ++ai)
#pragma unroll
                for (int m = 0; m < 4; ++m) {
                    const int row = rbase + ai * 128 + m * 16;
                    unsigned voff;
                    if (lat) voff = ((unsigned)(row >> 12) * 256u * 8192u + (unsigned)is_s * 4096u + (unsigned)(row & 4095)) * 2u + (unsigned)cl * cs2;
                    else { const int rr = row - ML; voff = ((unsigned)(rr >> 8) * 256u * 512u + (unsigned)is_s * 256u + (unsigned)(rr & 255)) * 2u + (unsigned)cl * cs2; }
#pragma unroll
                    for (int bj = 0; bj < 2; ++bj)
#pragma unroll
                        for (int n = 0; n < 2; ++n) {
                            const f32x4 v = acc[ai][bj][m][n];
#pragma unroll
                            for (int e = 0; e < 4; ++e)
                                __builtin_amdgcn_raw_buffer_store_b16((unsigned short)(pk2(v[e], 0.f) & 0xffffu), rs, (int)voff, (int)((unsigned)(bj * 128 + 4 * n + e) * cs2), 0);
                        }
                    asm volatile("" ::: "memory");
                }
        }
    }
};
struct EpiF32 {
    static constexpr bool PERM = false, AFTER_DRAIN = false;
    float* Y; int ldc;
    __device__ __forceinline__ void operator()(const f32x4 (&acc)[2][2][4][2], const Unit& u, int wr, int wc, int fr_, int fq_) const {
        int fr = fr_, fq = fq_; asm volatile("" : "+v"(fr), "+v"(fq));
        const int row0 = u.pm * 256 + wr * 64 + fr, col0 = u.pn * 256 + wc * 32 + 4 * fq;
#pragma unroll
        for (int ai = 0; ai < 2; ++ai)
#pragma unroll
            for (int m = 0; m < 4; ++m) { float* rp = Y + (size_t)(row0 + ai * 128 + m * 16) * ldc + col0;
#pragma unroll
                for (int bj = 0; bj < 2; ++bj)
#pragma unroll
                    for (int n = 0; n < 2; ++n) *(f32x4*)(rp + bj * 128 + n * 16) = acc[ai][bj][m][n]; }
    }
};
struct EpiSwiGLU {
    static constexpr bool PERM = true, AFTER_DRAIN = false;
    bf16_t* ACT;
    __device__ __forceinline__ void operator()(const f32x4 (&acc)[2][2][4][2], const Unit& u, int wr, int wc, int fr_, int fq_) const {
        int fr = fr_, fq = fq_; asm volatile("" : "+v"(fr), "+v"(fq));
        const int row0 = u.pm * 256 + wr * 64 + fr, col0 = u.pn * 128 + wc * 32 + 8 * fq;
#pragma unroll
        for (int ai = 0; ai < 2; ++ai)
#pragma unroll
            for (int m = 0; m < 4; ++m) {
                f32x4 g0 = acc[ai][0][m][0], g1 = acc[ai][0][m][1]; const f32x4 u0 = acc[ai][1][m][0], u1 = acc[ai][1][m][1];
#pragma unroll
                for (int e = 0; e < 4; ++e) { g0[e] = silu_f(g0[e]) * u0[e]; g1[e] = silu_f(g1[e]) * u1[e]; }
                u32x4 w; w.x = pk2(g0[0], g0[1]); w.y = pk2(g0[2], g0[3]); w.z = pk2(g1[0], g1[1]); w.w = pk2(g1[2], g1[3]);
                *(u32x4*)(ACT + (size_t)(row0 + ai * 128 + m * 16) * FFH + col0) = w;
            }
    }
};
struct EpiDft {
    static constexpr bool PERM = true, AFTER_DRAIN = false;
    bf16_t* MIX; int ctx;
    __device__ __forceinline__ void operator()(const f32x4 (&acc)[2][2][4][2], const Unit& u, int wr, int wc, int fr_, int fq_) const {
        int fr = fr_, fq = fq_; asm volatile("" : "+v"(fr), "+v"(fq));
        const int rowb = (ctx ? ML + u.pn * CTX : u.pn * SEQ + u.pm * 256) + wr * 64 + fr, col0 = 768 + wc * 32 + 8 * fq;
#pragma unroll
        for (int ai = 0; ai < 2; ++ai)
#pragma unroll
            for (int m = 0; m < 4; ++m)
#pragma unroll
                for (int bj = 0; bj < 2; ++bj) {
                    const f32x4 v0 = acc[ai][bj][m][0], v1 = acc[ai][bj][m][1];
                    u32x4 w; w.x = pk2(v0[0], v0[1]); w.y = pk2(v0[2], v0[3]); w.z = pk2(v1[0], v1[1]); w.w = pk2(v1[2], v1[3]);
                    *(u32x4*)(MIX + (size_t)(rowb + ai * 128 + m * 16) * DM + col0 + bj * 128) = w;
                }
    }
};
struct DftOrder {
    int G, c, off, n, npm;
    __device__ __forceinline__ bool next(int i, Unit& u) const { const int L = i * G + c - off; if (L < 0 || L >= n) return false; u.pm = L % npm; u.pn = L / npm; return true; }
    __device__ __forceinline__ void a_ready(const Unit&) const {}
    __device__ __forceinline__ void done(const Unit&) const {}
};

__device__ __forceinline__ void transpose_item(const float* W, int K, int Nsrc, bf16_t* WT, int dst_row0, int src_col0, int kb, LAS float* scr, int lane) {
    const int k0 = 64 * kb;
#pragma unroll 8
    for (int i = 0; i < 32; ++i) { const int kk = 2 * i + (lane >> 5); scr[kk * 33 + (lane & 31)] = W[(size_t)(k0 + kk) * Nsrc + src_col0 + (lane & 31)]; }
    asm volatile("s_waitcnt lgkmcnt(0)" ::: "memory");
    const int c = lane & 7;
#pragma unroll
    for (int j = 0; j < 4; ++j) { const int n = (lane >> 3) + 8 * j; const LAS float* s = scr + (8 * c) * 33 + n;
        u32x4 o; o.x = pk2(s[0 * 33], s[1 * 33]); o.y = pk2(s[2 * 33], s[3 * 33]); o.z = pk2(s[4 * 33], s[5 * 33]); o.w = pk2(s[6 * 33], s[7 * 33]);
        *(u32x4*)(WT + (size_t)(dst_row0 + n) * K + k0 + 8 * c) = o; }
    asm volatile("s_waitcnt lgkmcnt(0)" ::: "memory");
}
__device__ __forceinline__ void convert_weights(const float* const* in, unsigned char* ws, int layer, LAS unsigned char* lds, int wave, int lane, int gw, int NGW) {
    LAS float* scr = (LAS float*)(lds + wave * 16384);
    const float* w_in = in[0] + (size_t)layer * DM * INW;
    const float* w_out = in[1] + (size_t)layer * DM * DM;
    const float* w_fi = in[2] + (size_t)layer * DM * 2 * FFH;
    const float* w_fo = in[3] + (size_t)layer * FFH * DM;
    bf16_t* WIN = (bf16_t*)(ws + WS_WIN); bf16_t* WOUT = (bf16_t*)(ws + WS_WOUT); bf16_t* WFI = (bf16_t*)(ws + WS_WFI); bf16_t* WFO = (bf16_t*)(ws + WS_WFO);
    constexpr int I_IN = 16 * 104, I_OUT = 16 * 32, I_FI = 16 * 176, I_FO = 44 * 32, I_FOLD = 4096;
    constexpr int NIT = I_IN + I_OUT + I_FI + I_FO + I_FOLD;
    for (int it = gw; it < NIT; it += NGW) {
        int r = it;
        if (r < I_IN) { const int kb = r / 104, nb = r % 104; transpose_item(w_in, DM, INW, WIN, 32 * nb, 32 * nb, kb, scr, lane); continue; } r -= I_IN;
        if (r < I_OUT) { const int kb = r / 32, nb = r % 32; transpose_item(w_out, DM, DM, WOUT, 32 * nb, 32 * nb, kb, scr, lane); continue; } r -= I_OUT;
        if (r < I_FI) { const int kb = r / 176, nb = r % 176; const int tile = nb >> 3, wi = nb & 7;
            const int src = (wi < 4) ? (128 * tile + 32 * wi) : (FFH + 128 * tile + 32 * (wi - 4));
            transpose_item(w_fi, DM, 2 * FFH, WFI, 32 * nb, src, kb, scr, lane); continue; } r -= I_FI;
        if (r < I_FO) { const int kb = r / 32, nb = r % 32; transpose_item(w_fo, FFH, DM, WFO, 32 * nb, 32 * nb, kb, scr, lane); continue; } r -= I_FO;
        {
            const int k = r >> 2, g = r & 3;
            const float w = w_in[(size_t)k * INW + 3328 + g * 64 + lane] * 0.125f;
            float myc = 0.f, mys = 0.f;
            for (int k2 = 0; k2 < 64; ++k2) {
                const int ph = (lane * k2) & 63;
                const float cv = cospif((float)ph * (1.f / 32.f)), sv = sinpif((float)ph * (1.f / 32.f));
                const float a = wave_sum(w * cv), b = wave_sum(w * sv);
                if (lane == k2) { myc = a; mys = b; }
            }
            WIN[(size_t)(3328 + g * 64 + lane) * DM + k] = (bf16_t)(pk2(myc, 0.f) & 0xffffu);
            WIN[(size_t)(3584 + g * 64 + lane) * DM + k] = (bf16_t)(pk2(mys, 0.f) & 0xffffu);
        }
    }
}

__device__ __forceinline__ void row_update(const float* xin, const float* y, const float* gate, const float* gy, float* xout,
                                           const float* gh, const float* shift, const float* scale, bf16_t* hout, int lane) {
    f32x4 xv[4];
#pragma unroll
    for (int j = 0; j < 4; ++j) xv[j] = *(const f32x4*)(xin + 4 * lane + 256 * j);
    if (y) {
        f32x4 yv[4]; float ss = 0.f;
#pragma unroll
        for (int j = 0; j < 4; ++j) { yv[j] = *(const f32x4*)(y + 4 * lane + 256 * j); ss += (yv[j][0] * yv[j][0] + yv[j][1] * yv[j][1]) + (yv[j][2] * yv[j][2] + yv[j][3] * yv[j][3]); }
        const float rstd = rsqrtf(wave_sum(ss) * (1.f / DM) + EPS);
#pragma unroll
        for (int j = 0; j < 4; ++j) { const f32x4 gt = *(const f32x4*)(gate + 4 * lane + 256 * j), gg = *(const f32x4*)(gy + 4 * lane + 256 * j);
            xv[j] = xv[j] + gt * ((yv[j] * rstd) * gg); *(f32x4*)(xout + 4 * lane + 256 * j) = xv[j]; }
    }
    if (hout) {
        float ss = 0.f;
#pragma unroll
        for (int j = 0; j < 4; ++j) ss += (xv[j][0] * xv[j][0] + xv[j][1] * xv[j][1]) + (xv[j][2] * xv[j][2] + xv[j][3] * xv[j][3]);
        const float rstd = rsqrtf(wave_sum(ss) * (1.f / DM) + EPS);
#pragma unroll
        for (int j = 0; j < 4; ++j) { const f32x4 gg = *(const f32x4*)(gh + 4 * lane + 256 * j), sh = *(const f32x4*)(shift + 4 * lane + 256 * j), sc = *(const f32x4*)(scale + 4 * lane + 256 * j);
            const f32x4 hv = ((xv[j] * rstd) * gg) * (sc + 1.f) + sh;
            u32x2 w; w.x = pk2(hv[0], hv[1]); w.y = pk2(hv[2], hv[3]); *(u32x2*)(hout + 4 * lane + 256 * j) = w; }
    }
}

__device__ __forceinline__ void naive_hgrn(unsigned char* ws, float* sm, int b, int h, const float* onorm) {
    const int tid = opaque_tid(), vd = tid & 127, kq = tid >> 7, lane = tid & 63, wave = tid >> 6;
    float* sF = sm; float* sK = sm + 128; float* sQ = sm + 256; float* sP = sm + 384;
    const bf16_t* PQ = (const bf16_t*)(ws + WS_PQ); const bf16_t* PI = (const bf16_t*)(ws + WS_PQ + PSTRIDE); const bf16_t* PG = (const bf16_t*)(ws + WS_PQ + 2 * PSTRIDE);
    float* OF = (float*)(ws + WS_OF); bf16_t* MIX = (bf16_t*)(ws + WS_H);
    for (int dir = 0; dir < 2; ++dir) {
        const bf16_t* PL = (const bf16_t*)(ws + WS_PQ + (size_t)(3 + dir) * PSTRIDE);
        float S[32];
#pragma unroll
        for (int i = 0; i < 32; ++i) S[i] = 0.f;
        for (int step = 0; step < KEYS; ++step) {
            int row;
            if (step < CTX) { const int t = dir ? (CTX - 1 - step) : step; row = ML + b * CTX + t; }
            else { const int t = dir ? (SEQ - 1 - (step - CTX)) : (step - CTX); row = b * SEQ + t; }
            const size_t ro = (size_t)row * 512 + h * 128;
            if (tid < 128) { const float f = __expf(bf2f(PL[ro + tid])); sF[tid] = f; sK[tid] = 1.f - f; sQ[tid] = bf2f(PQ[ro + tid]); }
            const float v = bf2f(PI[ro + vd]);
            __syncthreads();
            float a = 0.f;
#pragma unroll
            for (int i = 0; i < 32; ++i) { const int kd = kq * 32 + i; S[i] = sF[kd] * S[i] + sK[kd] * v; a += sQ[kd] * S[i]; }
            sP[kq * 128 + vd] = a;
            __syncthreads();
            if (tid < 128) { float o = (sP[vd] + sP[128 + vd]) + (sP[256 + vd] + sP[384 + vd]); if (dir) o += OF[ro + vd]; OF[ro + vd] = o; }
        }
    }
    __syncthreads();
    for (int r = wave; r < KEYS; r += 8) {
        const int row = (r < CTX) ? (ML + b * CTX + r) : (b * SEQ + (r - CTX));
        const size_t ro = (size_t)row * 512 + h * 128;
        const float o0 = OF[ro + lane], o1 = OF[ro + 64 + lane];
        const float rstd = rsqrtf(wave_sum(o0 * o0 + o1 * o1) * (1.f / 128.f) + EPS);
        MIX[(size_t)row * DM + h * 128 + lane] = (bf16_t)(pk2(o0 * rstd * onorm[lane] * bf2f(PG[ro + lane]), 0.f) & 0xffffu);
        MIX[(size_t)row * DM + h * 128 + 64 + lane] = (bf16_t)(pk2(o1 * rstd * onorm[64 + lane] * bf2f(PG[ro + 64 + lane]), 0.f) & 0xffffu);
    }
    __syncthreads();
}

__device__ __forceinline__ void naive_attn(unsigned char* ws, float* sm, int unit, float lam, float outscale, const float* subln) {
    int b, h, qrow0, key0, nkeys;
    if (unit < 256) { b = unit >> 6; h = (unit >> 4) & 3; qrow0 = b * SEQ + (unit & 15) * 256; key0 = 0; nkeys = KEYS; }
    else { const int u2 = unit - 256; b = u2 >> 2; h = u2 & 3; qrow0 = ML + b * CTX; key0 = SEQ; nkeys = CTX; }
    const int tid = opaque_tid(), map = tid & 1, qi = tid >> 1, row = qrow0 + qi;
    const bf16_t* AQ = (const bf16_t*)(ws + WS_AQ); const bf16_t* AK = (const bf16_t*)(ws + WS_AK); const bf16_t* AV = (const bf16_t*)(ws + WS_AV);
    bf16_t* MIX = (bf16_t*)(ws + WS_H);
    float q[32], O[64];
    {
        const bf16_t* qp = AQ + (size_t)row * 256 + h * 64 + map * 32;
#pragma unroll
        for (int i = 0; i < 4; ++i) { const u32x4 w = *(const u32x4*)(qp + 8 * i);
#pragma unroll
            for (int e = 0; e < 4; ++e) { q[8 * i + 2 * e] = __uint_as_float(w[e] << 16); q[8 * i + 2 * e + 1] = __uint_as_float(w[e] & 0xffff0000u); } }
    }
#pragma unroll
    for (int d = 0; d < 64; ++d) O[d] = 0.f;
    float m = -1e30f, l = 0.f;
    float* sK = sm; float* sV = sm + 4096;
    for (int kt = 0; kt < nkeys; kt += 64) {
        __syncthreads();
        {
            const int key = tid >> 3, c8 = (tid & 7) * 8;
            const size_t go = (size_t)(b * KEYS + key0 + kt + key) * 256 + h * 64 + c8;
            const u32x4 kw = *(const u32x4*)(AK + go), vw = *(const u32x4*)(AV + go);
#pragma unroll
            for (int e = 0; e < 4; ++e) { sK[key * 64 + c8 + 2 * e] = __uint_as_float(kw[e] << 16); sK[key * 64 + c8 + 2 * e + 1] = __uint_as_float(kw[e] & 0xffff0000u);
                sV[key * 64 + c8 + 2 * e] = __uint_as_float(vw[e] << 16); sV[key * 64 + c8 + 2 * e + 1] = __uint_as_float(vw[e] & 0xffff0000u); }
        }
        __syncthreads();
        for (int j = 0; j < 64; ++j) {
            const float* kr = sK + j * 64 + map * 32;
            float s = 0.f;
#pragma unroll
            for (int d = 0; d < 32; ++d) s += q[d] * kr[d];
            if (s > m) { const float al = __builtin_amdgcn_exp2f(m - s); l *= al;
#pragma unroll
                for (int d = 0; d < 64; ++d) O[d] *= al;
                m = s; }
            const float p = __builtin_amdgcn_exp2f(s - m); l += p;
            const float* vr = sV + j * 64;
#pragma unroll
            for (int d = 0; d < 64; ++d) O[d] += p * vr[d];
        }
    }
    const float inv = 1.f / l;
    float ss = 0.f;
#pragma unroll
    for (int d = 0; d < 64; ++d) { const float o = O[d] * inv; const float other = __shfl_xor(o, 1); O[d] = o - lam * other; ss += O[d] * O[d]; }
    const float rstd = rsqrtf(ss * (1.f / 64.f) + EPS);
    if (map == 0) {
        bf16_t* op = MIX + (size_t)row * DM + 512 + h * 64;
#pragma unroll
        for (int i = 0; i < 8; ++i) { u32x4 w;
#pragma unroll
            for (int e = 0; e < 4; ++e) { const int d = 8 * i + 2 * e; w[e] = pk2(O[d] * rstd * subln[d] * outscale, O[d + 1] * rstd * subln[d + 1] * outscale); }
            *(u32x4*)(op + 8 * i) = w; }
    }
}

struct Args { const float* in[15]; float* out; unsigned char* ws; int ph_lo, ph_hi; };
constexpr int NPHASE = 2 + 8 * DEPTH;
typedef __attribute__((address_space(4))) const Args* cargs_t;
__device__ __forceinline__ cargs_t get_args() { __attribute__((address_space(4))) const void* p = (__attribute__((address_space(4))) const void*)__builtin_amdgcn_kernarg_segment_ptr(); asm volatile("" : "+s"(p) :: "memory"); return (cargs_t)p; }

__device__ __forceinline__ void phase_tables(cargs_t ap, int tid) {
    unsigned char* ws = ap->ws;
    const float* lb_logits = ap->in[9]; const float* da_lambda = ap->in[11];
    float* tab = (float*)(ws + WS_TAB);
    {
        const int pos = tid >> 3, f = tid & 7;
        const float inv_freq = 1.0f / powf(10000.0f, (float)(2 * f) / 16.0f);
        const float ang = (float)pos * inv_freq;
        tab[TAB_ROPEC / 4 + tid] = cosf(ang); tab[TAB_ROPES / 4 + tid] = sinf(ang);
    }
    if (tid < DEPTH) {
        const float* dl = da_lambda + tid * 4 * 32; float s01 = 0.f, s23 = 0.f;
        for (int d = 0; d < 32; ++d) { s01 += dl[d] * dl[32 + d]; s23 += dl[64 + d] * dl[96 + d]; }
        tab[TAB_LAM / 4 + tid] = expf(s01) - expf(s23) + (0.8f - 0.6f * expf(-0.3f * (float)tid));
    }
    for (int i = tid; i < 2 * 512; i += NTHREADS) {
        const int dir = i >> 9, ch = i & 511; float lg[DEPTH], mx = -1e30f;
#pragma unroll
        for (int l = 0; l < DEPTH; ++l) { lg[l] = lb_logits[(size_t)(dir * DEPTH + l) * 512 + ch]; mx = fmaxf(mx, lg[l]); }
        float den = 0.f;
#pragma unroll
        for (int l = 0; l < DEPTH; ++l) { lg[l] = expf(lg[l] - mx); den += lg[l]; }
        float cum = 0.f;
#pragma unroll
        for (int l = 0; l < DEPTH; ++l) { if (l > 0) cum += lg[l] / den; tab[TAB_LB / 4 + (l * 2 + dir) * 512 + ch] = cum; }
    }
}
__device__ __forceinline__ void phase_mod(cargs_t ap, float* smf, int tid, int bid, int G) {
    const float* c_in = ap->in[1]; const float* cctx_in = ap->in[3]; const float* w_mod = ap->in[4]; const float* b_mod = ap->in[5];
    float* MOD = (float*)(ap->ws + WS_MOD);
    float* sc = smf;
    float* red = smf + 5 * 1024;
    for (int i = tid; i < 5 * 1024; i += NTHREADS) { const int id = i >> 10, k = i & 1023; const float cv = (id < 4) ? c_in[id * 1024 + k] : cctx_in[k]; sc[i] = silu_f(cv); }
    __syncthreads();
    for (int it = bid; it < DEPTH * 96; it += G) {
        const int l = it / 96, jb = it % 96, ks = tid >> 6, j = tid & 63;
        const float* wp = w_mod + ((size_t)l * DM + ks * 128) * (NMOD * DM) + jb * 64 + j;
        float a[5] = {0.f, 0.f, 0.f, 0.f, 0.f};
        for (int k = 0; k < 128; ++k) { const float w = wp[(size_t)k * (NMOD * DM)];
#pragma unroll
            for (int id = 0; id < 5; ++id) a[id] += sc[id * 1024 + ks * 128 + k] * w; }
#pragma unroll
        for (int id = 0; id < 5; ++id) red[(ks * 5 + id) * 64 + j] = a[id];
        __syncthreads();
        if (tid < 5 * 64) { const int id = tid >> 6, jj = tid & 63; float s = b_mod[(size_t)l * NMOD * DM + jb * 64 + jj];
            for (int k2 = 0; k2 < 8; ++k2) s += red[(k2 * 5 + id) * 64 + jj];
            MOD[((size_t)l * 5 + id) * (NMOD * DM) + jb * 64 + jj] = s; }
        __syncthreads();
    }
}
__device__ __forceinline__ void phase_dftmat(cargs_t ap, float* smf, int tid, int bid, int G) {
    unsigned char* ws = ap->ws;
    float* ct = smf;
    __syncthreads();
    for (int i = tid; i < 4096; i += NTHREADS) ct[i] = cospif((float)i * (1.f / 2048.f));
    __syncthreads();
    bf16_t* F = (bf16_t*)(ws + WS_F);
    for (int k1 = bid; k1 < SEQ; k1 += G) {
#pragma unroll
        for (int hh = 0; hh < 2; ++hh) {
            const int c0 = hh * 4096 + tid * 8; float v[8];
#pragma unroll
            for (int e = 0; e < 8; ++e) { const int t = (c0 + e) & 4095; const int ph = (k1 * t) & 4095;
                v[e] = hh ? -ct[(ph - 1024) & 4095] * (1.f / 64.f) : ct[ph] * (1.f / 64.f); }
            u32x4 w; w.x = pk2(v[0], v[1]); w.y = pk2(v[2], v[3]); w.z = pk2(v[4], v[5]); w.w = pk2(v[6], v[7]);
            *(u32x4*)(F + (size_t)k1 * 8192 + c0) = w;
        }
    }
    bf16_t* FC = (bf16_t*)(ws + WS_FC);
    for (int k1 = bid; k1 < CTX; k1 += G) {
        const int t = tid & 255, ph = ((k1 * t) & 255) * 16;
        const float v = (tid < 256) ? ct[ph] * (1.f / 16.f) : -ct[(ph - 1024) & 4095] * (1.f / 16.f);
        FC[(size_t)k1 * 512 + tid] = (bf16_t)(pk2(v, 0.f) & 0xffffu);
    }
    __syncthreads();
}
__device__ __forceinline__ void phase_h0(cargs_t ap, int lane, int gw, int NGW) {
    unsigned char* ws = ap->ws;
    const float* x_in = ap->in[0]; const float* ctx_in = ap->in[2]; const float* norm_g = ap->in[6];
    const float* MOD = (const float*)(ws + WS_MOD); bf16_t* H = (bf16_t*)(ws + WS_H);
    for (int r = gw; r < MR; r += NGW) {
        const int id = (r < ML) ? (r >> 12) : 4;
        const float* xin = (r < ML) ? x_in + (size_t)r * DM : ctx_in + (size_t)(r - ML) * DM;
        const float* md = MOD + (size_t)id * (NMOD * DM);
        row_update(xin, nullptr, nullptr, nullptr, nullptr, norm_g, md, md + DM, H + (size_t)r * DM, lane);
    }
}
__device__ __forceinline__ void phase_inproj(cargs_t ap, LAS unsigned char* lds, int l, int G, int bid) {
    unsigned char* ws = ap->ws;
    pg8::Gemm g{(const bf16_t*)(ws + WS_H), (const bf16_t*)(ws + WS_WIN), MR, INW2, DM}; pg8::StaticOrder S; S.init(MR, INW2, G, bid);
    EpiInProj E{ws, (const float*)(ws + WS_TAB + TAB_LB) + l * 1024};
    pg8::gemm_phase<EpiInProj, pg8::StaticOrder, true, true>(lds, g, S, E);
}
__device__ __forceinline__ void phase_dft(cargs_t ap, LAS unsigned char* lds, int G, int bid) {
    unsigned char* ws = ap->ws;
    { pg8::Gemm g{(const bf16_t*)(ws + WS_F), (const bf16_t*)(ws + WS_BTL), SEQ, NB * 256, 2 * SEQ}; DftOrder S{G, bid, 0, 64, 16};
      EpiDft E{(bf16_t*)(ws + WS_H), 0}; pg8::gemm_phase<EpiDft, DftOrder, true, true>(lds, g, S, E); }
    { pg8::Gemm g{(const bf16_t*)(ws + WS_FC), (const bf16_t*)(ws + WS_BTC), CTX, NB * 256, 2 * CTX}; DftOrder S{G, bid, 64, 4, 1};
      EpiDft E{(bf16_t*)(ws + WS_H), 1}; pg8::gemm_phase<EpiDft, DftOrder, true, true>(lds, g, S, E); }
}
__device__ __forceinline__ void phase_mixers_naive(cargs_t ap, float* smf, int l, int G, int bid) {
    unsigned char* ws = ap->ws;
    if (bid < 16) naive_hgrn(ws, smf, bid >> 2, bid & 3, ap->in[10] + l * 128);
    else {
        const float lam = ((const float*)(ws + WS_TAB + TAB_LAM))[l];
        const float lam_init = 0.8f - 0.6f * expf(-0.3f * (float)l);
        const float* subln = ap->in[12] + l * 64;
        for (int u = bid - 16; u < 272; u += G - 16) naive_attn(ws, smf, u, lam, 1.f - lam_init, subln);
    }
}
__device__ __forceinline__ void phase_outproj(cargs_t ap, LAS unsigned char* lds, int G, int bid) {
    unsigned char* ws = ap->ws;
    pg8::Gemm g{(const bf16_t*)(ws + WS_H), (const bf16_t*)(ws + WS_WOUT), MR, DM, DM}; pg8::StaticOrder S; S.init(MR, DM, G, bid);
    EpiF32 E{(float*)(ws + WS_Y), DM}; pg8::gemm_phase<EpiF32, pg8::StaticOrder, true, true>(lds, g, S, E);
}
__device__ __forceinline__ void phase_r1(cargs_t ap, int l, int lane, int gw, int NGW) {
    unsigned char* ws = ap->ws;
    const float* x_in = ap->in[0]; const float* ctx_in = ap->in[2]; const float* norm_g = ap->in[6]; float* out = ap->out;
    const float* MOD = (const float*)(ws + WS_MOD); bf16_t* H = (bf16_t*)(ws + WS_H); float* XC = (float*)(ws + WS_XC); const float* Y = (const float*)(ws + WS_Y);
    const float* ng = norm_g + (size_t)l * 4 * DM;
    for (int r = gw; r < MR; r += NGW) {
        const int id = (r < ML) ? (r >> 12) : 4;
        const float* md = MOD + ((size_t)l * 5 + id) * (NMOD * DM);
        const float* xin; float* xout;
        if (r < ML) { xout = out + (size_t)r * DM; xin = (l == 0) ? x_in + (size_t)r * DM : xout; }
        else { xout = XC + (size_t)(r - ML) * DM; xin = (l == 0) ? ctx_in + (size_t)(r - ML) * DM : xout; }
        row_update(xin, Y + (size_t)r * DM, md + 2 * DM, ng + DM, xout, ng + 2 * DM, md + 3 * DM, md + 4 * DM, H + (size_t)r * DM, lane);
    }
}
__device__ __forceinline__ void phase_ffnin(cargs_t ap, LAS unsigned char* lds, int G, int bid) {
    unsigned char* ws = ap->ws;
    pg8::Gemm g{(const bf16_t*)(ws + WS_H), (const bf16_t*)(ws + WS_WFI), MR, 2 * FFH, DM}; pg8::StaticOrder S; S.init(MR, 2 * FFH, G, bid);
    EpiSwiGLU E{(bf16_t*)(ws + WS_ACT)}; pg8::gemm_phase<EpiSwiGLU, pg8::StaticOrder, true, true>(lds, g, S, E);
}
__device__ __forceinline__ void phase_ffnout(cargs_t ap, LAS unsigned char* lds, int G, int bid) {
    unsigned char* ws = ap->ws;
    pg8::Gemm g{(const bf16_t*)(ws + WS_ACT), (const bf16_t*)(ws + WS_WFO), MR, DM, FFH}; pg8::StaticOrder S; S.init(MR, DM, G, bid);
    EpiF32 E{(float*)(ws + WS_Y), DM}; pg8::gemm_phase<EpiF32, pg8::StaticOrder, true, true>(lds, g, S, E);
}
__device__ __forceinline__ void phase_r2(cargs_t ap, int l, int lane, int gw, int NGW) {
    unsigned char* ws = ap->ws;
    const float* norm_g = ap->in[6]; float* out = ap->out;
    const float* MOD = (const float*)(ws + WS_MOD); bf16_t* H = (bf16_t*)(ws + WS_H); float* XC = (float*)(ws + WS_XC); const float* Y = (const float*)(ws + WS_Y);
    const bool more = (l + 1 < DEPTH);
    const float* ng = norm_g + (size_t)l * 4 * DM;
    const float* ng2 = norm_g + (size_t)(more ? l + 1 : l) * 4 * DM;
    for (int r = gw; r < MR; r += NGW) {
        const int id = (r < ML) ? (r >> 12) : 4;
        const float* md = MOD + ((size_t)l * 5 + id) * (NMOD * DM);
        float* xs = (r < ML) ? out + (size_t)r * DM : XC + (size_t)(r - ML) * DM;
        const float* md2 = MOD + ((size_t)(more ? l + 1 : l) * 5 + id) * (NMOD * DM);
        row_update(xs, Y + (size_t)r * DM, md + 5 * DM, ng + 3 * DM, xs, ng2, md2, md2 + DM, more ? H + (size_t)r * DM : nullptr, lane);
    }
}
__device__ __forceinline__ void phase_weights(cargs_t ap, LAS unsigned char* lds, int layer, int wave, int lane, int gw, int NGW) {
    const float* in4[4] = {ap->in[7], ap->in[8], ap->in[13], ap->in[14]};
    convert_weights(in4, ap->ws, layer, lds, wave, lane, gw, NGW);
}

__global__ void __launch_bounds__(NTHREADS, 2) fwd_kernel(Args args) {
    extern __shared__ __attribute__((aligned(16))) unsigned char lds_raw[];
    LAS unsigned char* lds = (LAS unsigned char*)lds_raw;
    volatile LAS unsigned* MISC = (volatile LAS unsigned*)(lds + MISC_OFF);
    const int G = gridDim.x, bid = blockIdx.x, NGW = G * 8;
#define TID (opaque_tid())
#define LANE (opaque_tid() & 63)
#define WAVE (__builtin_amdgcn_readfirstlane(opaque_tid() >> 6))
#define GW (bid * 8 + WAVE)
    const int lo = args.ph_lo, hi = args.ph_hi;
    const bool single = (lo == 0 && hi == NPHASE);
    for (int u = threadIdx.x; u < (LDS_BYTES - LDSCTL_OFF) / 4; u += NTHREADS) ((LAS unsigned*)(lds + LDSCTL_OFF))[u] = 0u;
    __syncthreads();
    XcdBarrier bar; bar.bar = (unsigned*)(args.ws + WS_CTL) + CW_BAR; bar.x = 0; bar.st = nullptr;
    if (single) bar = xcd_barrier_post((unsigned*)(args.ws + WS_CTL) + CW_BAR, MISC + 8);
    bool first_sync = true;
    float* smf = (float*)lds_raw;
#define IN(k) (lo <= (k) && (k) < hi)
#define SEAM(k) do { if (IN(k) && IN((k) + 1)) { if (first_sync) { __threadfence(); cg::this_grid().sync(); first_sync = false; } else xcd_barrier(bar); } } while (0)

    if (IN(0)) {
        if (bid == 0) phase_tables(get_args(), TID);
        phase_mod(get_args(), smf, TID, bid, G);
        phase_dftmat(get_args(), smf, TID, bid, G);
        phase_weights(get_args(), lds, 0, WAVE, LANE, GW, NGW);
    }
    SEAM(0);
    if (IN(1)) phase_h0(get_args(), LANE, GW, NGW);
    SEAM(1);
#pragma nounroll
    for (int l = 0; l < DEPTH; ++l) {
        const int pb = 2 + 8 * l;
        if (IN(pb + 0)) phase_inproj(get_args(), lds, l, G, bid);
        SEAM(pb + 0);
        if (IN(pb + 1)) phase_dft(get_args(), lds, G, bid);
        SEAM(pb + 1);
        if (IN(pb + 2)) phase_mixers_naive(get_args(), smf, l, G, bid);
        SEAM(pb + 2);
        if (IN(pb + 3)) phase_outproj(get_args(), lds, G, bid);
        SEAM(pb + 3);
        if (IN(pb + 4)) phase_r1(get_args(), l, LANE, GW, NGW);
        SEAM(pb + 4);
        if (IN(pb + 5)) phase_ffnin(get_args(), lds, G, bid);
        SEAM(pb + 5);
        if (IN(pb + 6)) phase_ffnout(get_args(), lds, G, bid);
        SEAM(pb + 6);
        if (IN(pb + 7)) {
            phase_r2(get_args(), l, LANE, GW, NGW);
            if (l + 1 < DEPTH) phase_weights(get_args(), lds, l + 1, WAVE, LANE, GW, NGW);
        }
        SEAM(pb + 7);
    }
#undef IN
#undef SEAM
}

#ifndef N_LAUNCH_MODE
#define N_LAUNCH_MODE 1
#endif
extern "C" void kernel_launch(void* const* d_in, const int* in_sizes, int n_in, void* d_out, int out_size, void* d_ws, size_t ws_size, hipStream_t stream) {
    static int grid = 0;
    if (grid == 0) {
        int dev = 0, cus = 0, per_cu = 0;
        hipGetDevice(&dev);
        hipDeviceGetAttribute(&cus, hipDeviceAttributeMultiprocessorCount, dev);
        hipFuncSetAttribute((const void*)fwd_kernel, hipFuncAttributeMaxDynamicSharedMemorySize, LDS_BYTES);
        hipOccupancyMaxActiveBlocksPerMultiprocessor(&per_cu, (const void*)fwd_kernel, NTHREADS, LDS_BYTES);
        (void)hipGetLastError();
        if (per_cu < 1) { fprintf(stderr, "kernel_launch: occupancy query says %d blocks per CU\n", per_cu); per_cu = 1; }
        grid = cus;
        if (ws_size < WS_END || ws_size < WS_ACT + (size_t)MR * FFH * 2) fprintf(stderr, "kernel_launch: workspace too small: %zu\n", ws_size);
    }
    hipMemsetAsync((char*)d_ws + WS_CTL, 0, CTL_ZERO_BYTES, stream);
    Args a; memset(&a, 0, sizeof(a));
    for (int i = 0; i < 15; ++i) a.in[i] = (const float*)d_in[i];
    a.out = (float*)d_out; a.ws = (unsigned char*)d_ws;
#if N_LAUNCH_MODE == 1
    a.ph_lo = 0; a.ph_hi = NPHASE;
    void* kargs[] = {&a};
    hipError_t e = hipLaunchCooperativeKernel((const void*)fwd_kernel, dim3(grid), dim3(NTHREADS), kargs, LDS_BYTES, stream);
    if (e != hipSuccess) fprintf(stderr, "cooperative launch failed: %s (grid %d)\n", hipGetErrorString(e), grid);
#else
    for (int p = 0; p < NPHASE; ++p) { a.ph_lo = p; a.ph_hi = p + 1; hipLaunchKernelGGL(fwd_kernel, dim3(grid), dim3(NTHREADS), LDS_BYTES, stream, a); }
#endif
}
```

```cpp
#include <hip/hip_runtime.h>
#include <hip/hip_cooperative_groups.h>
#include <cstdio>
#include <cstdint>
#include <cstring>
namespace cg = cooperative_groups;
__device__ __forceinline__ int opaque_tid() { int t = threadIdx.x; asm volatile("" : "+v"(t)); return t; }
namespace pg8 {
#define PG8_LAS __attribute__((address_space(3)))
typedef unsigned short bf16_t;
typedef short bf16x8 __attribute__((ext_vector_type(8)));
typedef float f32x4 __attribute__((ext_vector_type(4)));
typedef unsigned u32x4 __attribute__((ext_vector_type(4)));
constexpr int BM = 256, BK = 64, HALF = 128, HTB = HALF * BK * 2  , STAGE_BYTES = 8 * HTB, NXCD = 8, WGM = 8;

__host__ __device__ __forceinline__ int lds_byte(int r, int c) { const int st = (r >> 4) * 2 + (c >> 5), rr = r & 15, cc = c & 31, ob = rr * 64 + cc * 2; return st * 1024 + (ob ^ (((ob >> 9) & 1) << 5)); }
__host__ __device__ __forceinline__ void stage_rc(int b, int& R, int& C) { const int st = b / 1024, sb = b % 1024, swz = sb ^ (((sb >> 9) & 1) << 5); R = (st >> 1) * 16 + swz / 64; C = (st & 1) * 32 + (swz % 64) / 2; }
__host__ __device__ __forceinline__ int perm32(int rho) { const int n = rho >> 4, i = rho & 15; return 8 * (i >> 2) + 4 * n + (i & 3); }

struct Unit { int pm, pn; };
struct Gemm { const bf16_t* A; const bf16_t* Bt; int M, N, K; };

struct StaticOrder {
    int nM, nN, nwg, G, c;
    __host__ __device__ void init(int M, int N, int G_, int c_) { nM = M / BM; nN = N / BM; nwg = nM * nN; G = G_; c = c_; }
    __host__ __device__ bool next(int i, Unit& u) const {
        const long L = (long)i * G + c; if (L >= nwg) return false;
        int wgid = (int)L; { const int q = nwg / NXCD, r = nwg % NXCD, xcd = wgid % NXCD, off = wgid / NXCD; wgid = (xcd < r ? xcd * (q + 1) : r * (q + 1) + (xcd - r) * q) + off; }
        const int nig = WGM * nN, gid = wgid / nig, fm = gid * WGM, gsz = (nM - fm) < WGM ? (nM - fm) : WGM;
        u.pm = fm + ((wgid % nig) % gsz); u.pn = (wgid % nig) / gsz; return true;
    }
    __device__ __forceinline__ void a_ready(const Unit&) const {}
    __device__ __forceinline__ void done(const Unit&) const {}
};

__device__ __forceinline__ unsigned cvt_pk_bf16(float lo, float hi) { unsigned r; asm volatile("v_cvt_pk_bf16_f32 %0, %1, %2" : "=v"(r) : "v"(lo), "v"(hi)); return r; }
typedef float f32x2 __attribute__((ext_vector_type(2)));
template <class Epi, class Sched, bool ALIGN_EPI = false, bool SP2 = false>
__device__ __forceinline__ void gemm_phase(PG8_LAS unsigned char* lds, const Gemm g, const Sched& S, const Epi& E) {
    const int tid = opaque_tid(), wid = __builtin_amdgcn_readfirstlane(tid >> 6), lane = tid & 63, wr = wid >> 2, wc = wid & 3, fr = lane & 15, fq = lane >> 4;
    const int K = g.K, nt = K / BK;
    unsigned voffA[2], voffB[2];
#pragma unroll
    for (int i = 0; i < 2; ++i) { int R, C; stage_rc(tid * 16 + i * 8192, R, C); const int Rb = Epi::PERM ? ((R & ~31) + perm32(R & 31)) : R;
        voffA[i] = (unsigned)(R * K + C) * 2u; voffB[i] = (unsigned)(Rb * K + C) * 2u; }
    const size_t kstep = (size_t)(BK * 2);
    const size_t hstep = (size_t)HALF * K * 2;
    const size_t tstep = 2 * hstep;
    const unsigned ldsw = (unsigned)wid * 1024u;
    const int aoff = lds_byte(wr * 64 + fr, fq * 8), boff = lds_byte(wc * 32 + fr, fq * 8);
#define PG8_SA(b, h) (((b) * 2 + (h)) * HTB)
#define PG8_SB(b, h) ((4 + (b) * 2 + (h)) * HTB)
#define PG8_STAGE(bufoff, gbase, voff) do { _Pragma("unroll") for (int _i = 0; _i < 2; ++_i) \
        __builtin_amdgcn_global_load_lds((const unsigned*)((const char*)(gbase) + (voff)[_i]), (PG8_LAS unsigned*)(lds + (bufoff) + ldsw + _i * 8192), 16, 0, 0); } while (0)
#define PG8_LDA(dst, b, h) do { _Pragma("unroll") for (int m = 0; m < 4; ++m) _Pragma("unroll") for (int k = 0; k < 2; ++k) dst[m][k] = *(const PG8_LAS bf16x8*)(lds + PG8_SA(b, h) + aoff + m * 2048 + k * 1024); } while (0)
#define PG8_LDB(dst, b, h) do { _Pragma("unroll") for (int n = 0; n < 2; ++n) _Pragma("unroll") for (int k = 0; k < 2; ++k) dst[n][k] = *(const PG8_LAS bf16x8*)(lds + PG8_SB(b, h) + boff + n * 2048 + k * 1024); } while (0)
#define PG8_MMA(ai, bj, At, Bt) do { __builtin_amdgcn_s_setprio(1); _Pragma("unroll") for (int m = 0; m < 4; ++m) _Pragma("unroll") for (int n = 0; n < 2; ++n) _Pragma("unroll") for (int k = 0; k < 2; ++k) \
        acc[ai][bj][m][n] = __builtin_amdgcn_mfma_f32_16x16x32_bf16(Bt[n][k], At[m][k], acc[ai][bj][m][n], 0, 0, 0); __builtin_amdgcn_s_setprio(0); } while (0)
#define PG8_WAIT_V(n) asm volatile("s_waitcnt vmcnt(" #n ")" ::: "memory")
#define PG8_WAIT_L(n) asm volatile("s_waitcnt lgkmcnt(" #n ")" ::: "memory")
#define PG8_BAR __builtin_amdgcn_s_barrier()
#define PG8_SCHED __builtin_amdgcn_sched_barrier(0)
    Unit cur, nxt; int ui = 0;
    if (!S.next(0, cur)) return;
    f32x4 acc[2][2][4][2];
#pragma unroll
    for (int a = 0; a < 2; ++a)
#pragma unroll
        for (int b = 0; b < 2; ++b)
#pragma unroll
            for (int m = 0; m < 4; ++m)
#pragma unroll
                for (int n = 0; n < 2; ++n) acc[a][b][m][n] = (f32x4){0.f, 0.f, 0.f, 0.f};
    bf16x8 At[4][2], B0[2][2], B1[2][2];
    const char* cA = (const char*)g.A + (size_t)cur.pm * tstep; const char* cB = (const char*)g.Bt + (size_t)cur.pn * tstep;
    S.a_ready(cur);
    if constexpr (SP2) {
        PG8_STAGE(PG8_SB(0, 0), cB, voffB); PG8_STAGE(PG8_SB(0, 1), cB + hstep, voffB); PG8_STAGE(PG8_SA(0, 0), cA, voffA); PG8_STAGE(PG8_SA(0, 1), cA + hstep, voffA);
        if (wr == 1) PG8_BAR;
        PG8_WAIT_V(2); PG8_BAR;
        PG8_STAGE(PG8_SB(1, 0), cB + kstep, voffB); PG8_STAGE(PG8_SA(1, 0), cA + kstep, voffA); PG8_STAGE(PG8_SB(1, 1), cB + hstep + kstep, voffB);
        PG8_WAIT_V(6); PG8_BAR;
    } else {
        PG8_STAGE(PG8_SB(0, 0), cB, voffB); PG8_STAGE(PG8_SA(0, 0), cA, voffA); PG8_STAGE(PG8_SB(0, 1), cB + hstep, voffB); PG8_STAGE(PG8_SA(0, 1), cA + hstep, voffA);
        if (wr == 1) PG8_BAR;
        PG8_WAIT_V(4); PG8_BAR;
        PG8_STAGE(PG8_SB(1, 0), cB + kstep, voffB); PG8_STAGE(PG8_SA(1, 0), cA + kstep, voffA); PG8_STAGE(PG8_SB(1, 1), cB + hstep + kstep, voffB);
        PG8_WAIT_V(6); PG8_BAR;
    }
    for (;;) {
        const bool has_next = S.next(ui + 1, nxt);
        const char* nA = has_next ? (const char*)g.A + (size_t)nxt.pm * tstep : cA; const char* nB = has_next ? (const char*)g.Bt + (size_t)nxt.pn * tstep : cB;
        for (int t = 0; t < nt; t += 2) {
            const bool last = (t == nt - 2);
            const char* a1 = cA + (size_t)(t + 1) * kstep;
            const char* a2 = last ? nA : cA + (size_t)(t + 2) * kstep; const char* b2 = last ? nB : cB + (size_t)(t + 2) * kstep;
            const char* a3 = a2 + kstep; const char* b3 = b2 + kstep;
            if (last && has_next) S.a_ready(nxt);
            if constexpr (SP2) {
            PG8_LDB(B0, 0, 0); PG8_LDB(B1, 0, 1); PG8_SCHED; PG8_LDA(At, 0, 0); PG8_STAGE(PG8_SA(1, 1), a1 + hstep, voffA);
            PG8_WAIT_V(8); PG8_WAIT_L(0); PG8_BAR; PG8_MMA(0, 0, At, B0); PG8_MMA(0, 1, At, B1); PG8_BAR; PG8_SCHED;
            PG8_LDA(At, 0, 1); PG8_STAGE(PG8_SB(0, 0), b2, voffB); PG8_STAGE(PG8_SB(0, 1), b2 + hstep, voffB); PG8_STAGE(PG8_SA(0, 0), a2, voffA);
            PG8_WAIT_V(8); PG8_WAIT_L(0); PG8_BAR; PG8_MMA(1, 0, At, B0); PG8_MMA(1, 1, At, B1); PG8_BAR; PG8_SCHED;
            PG8_LDB(B0, 1, 0); PG8_LDB(B1, 1, 1); PG8_SCHED; PG8_LDA(At, 1, 0); PG8_STAGE(PG8_SA(0, 1), a2 + hstep, voffA);
            PG8_WAIT_V(8); PG8_WAIT_L(0); PG8_BAR; PG8_MMA(0, 0, At, B0); PG8_MMA(0, 1, At, B1); PG8_BAR; PG8_SCHED;
            PG8_LDA(At, 1, 1); PG8_STAGE(PG8_SB(1, 0), b3, voffB); PG8_STAGE(PG8_SB(1, 1), b3 + hstep, voffB); PG8_STAGE(PG8_SA(1, 0), a3, voffA);
            PG8_WAIT_V(8); PG8_WAIT_L(0); PG8_BAR; PG8_MMA(1, 0, At, B0); PG8_MMA(1, 1, At, B1); PG8_BAR; PG8_SCHED;
            } else {
            PG8_LDB(B0, 0, 0); PG8_SCHED; PG8_LDA(At, 0, 0); PG8_STAGE(PG8_SA(1, 1), a1 + hstep, voffA);
            PG8_WAIT_L(8); PG8_BAR; PG8_WAIT_L(0); PG8_MMA(0, 0, At, B0); PG8_BAR; PG8_SCHED;
            PG8_LDB(B1, 0, 1); PG8_STAGE(PG8_SB(0, 0), b2, voffB);
            PG8_BAR; PG8_WAIT_L(0); PG8_MMA(0, 1, At, B1); PG8_BAR;
            PG8_LDA(At, 0, 1); PG8_STAGE(PG8_SA(0, 0), a2, voffA);
            PG8_BAR; PG8_WAIT_L(0); PG8_MMA(1, 0, At, B0); PG8_BAR; PG8_SCHED;
            PG8_STAGE(PG8_SB(0, 1), b2 + hstep, voffB);
            PG8_WAIT_V(6); PG8_BAR; PG8_MMA(1, 1, At, B1); PG8_BAR;
            PG8_LDB(B0, 1, 0); PG8_SCHED; PG8_LDA(At, 1, 0); PG8_STAGE(PG8_SA(0, 1), a2 + hstep, voffA);
            PG8_WAIT_L(8); PG8_BAR; PG8_WAIT_L(0); PG8_MMA(0, 0, At, B0); PG8_BAR; PG8_SCHED;
            PG8_LDB(B1, 1, 1); PG8_STAGE(PG8_SB(1, 0), b3, voffB);
            PG8_BAR; PG8_WAIT_L(0); PG8_MMA(0, 1, At, B1); PG8_BAR;
            PG8_LDA(At, 1, 1); PG8_STAGE(PG8_SA(1, 0), a3, voffA);
            PG8_BAR; PG8_WAIT_L(0); PG8_MMA(1, 0, At, B0); PG8_BAR; PG8_SCHED;
            PG8_STAGE(PG8_SB(1, 1), b3 + hstep, voffB);
            PG8_WAIT_V(6); PG8_BAR; PG8_MMA(1, 1, At, B1); PG8_BAR;
            }
        }
        if constexpr (ALIGN_EPI) { if (wr == 0) PG8_BAR; }
        if constexpr (!Epi::AFTER_DRAIN) { E(acc, cur, wr, wc, fr, fq); S.done(cur); }
        if (!has_next) break;
#pragma unroll
        for (int a = 0; a < 2; ++a)
#pragma unroll
            for (int b = 0; b < 2; ++b)
#pragma unroll
                for (int m = 0; m < 4; ++m)
#pragma unroll
                    for (int n = 0; n < 2; ++n) acc[a][b][m][n] = (f32x4){0.f, 0.f, 0.f, 0.f};
        cur = nxt; cA = nA; cB = nB; ++ui;
        if constexpr (ALIGN_EPI) { if (wr == 1) PG8_BAR; }
    }
    PG8_WAIT_V(0);
    if constexpr (!ALIGN_EPI) { if (wr == 0) PG8_BAR; }
    PG8_BAR;
    if constexpr (Epi::AFTER_DRAIN) { E.fused(acc, cur, wr, wc, fr, fq, lds, wid, lane); S.done(cur); }
#undef PG8_SA
#undef PG8_SB
#undef PG8_STAGE
#undef PG8_LDA
#undef PG8_LDB
#undef PG8_MMA
#undef PG8_WAIT_V
#undef PG8_WAIT_L
#undef PG8_BAR
#undef PG8_SCHED
}
}

constexpr int DM = 1024, NB = 4, SEQ = 4096, CTX = 256, DEPTH = 4;
constexpr int ML = NB * SEQ, MC = NB * CTX, MR = ML + MC;
constexpr int KEYS = SEQ + CTX;
constexpr int INW = 3584, INW2 = 3840, FFH = 2816, NMOD = 6;
constexpr float EPS = 1e-6f;
constexpr float QSCALE = 0.17677669529663687f * 1.4426950408889634f;

constexpr size_t MiB = 1u << 20;
constexpr size_t WS_CTL = 0, CTL_ZERO_BYTES = 1 * MiB;
constexpr size_t WS_MOD = 1 * MiB;
constexpr size_t WS_TAB = 2 * MiB;
constexpr size_t TAB_ROPEC = 0, TAB_ROPES = 2048, TAB_LAM = 4096, TAB_LB = 8192;
constexpr size_t WS_FC = 3 * MiB;
constexpr size_t WS_XC = 4 * MiB;
constexpr size_t WS_WIN = 8 * MiB;
constexpr size_t WS_WOUT = 16 * MiB;
constexpr size_t WS_WFI = 18 * MiB;
constexpr size_t WS_WFO = 29 * MiB;
constexpr size_t WS_F = 36 * MiB;
constexpr size_t WS_H = 100 * MiB;
constexpr size_t WS_B = 134 * MiB;
constexpr size_t PSTRIDE = 17 * MiB;
constexpr size_t WS_PQ = WS_B;
constexpr size_t WS_AQ = WS_B + 85 * MiB;
constexpr size_t WS_AK = WS_AQ + 9 * MiB;
constexpr size_t WS_AV = WS_AK + 9 * MiB;
constexpr size_t WS_BTL = WS_AV + 9 * MiB;
constexpr size_t WS_BTC = WS_BTL + 16 * MiB;
constexpr size_t WS_Y = WS_B;
constexpr size_t WS_ACT = WS_B + 68 * MiB;
constexpr size_t WS_END = WS_BTC + 1 * MiB + 34 * MiB + 17 * MiB + 4 * MiB + 34 * MiB;
static_assert(WS_ACT + (size_t)MR * FFH * 2 <= 384 * MiB && WS_END <= 384 * MiB, "ws map");

constexpr int CW_BAR = 4096;

constexpr int RING_BYTES = 131072;
constexpr int LDSCTL_OFF = RING_BYTES, MISC_OFF = LDSCTL_OFF + 320;
constexpr int LDS_BYTES = 147456;
constexpr int NTHREADS = 512;

#define LAS __attribute__((address_space(3)))
typedef unsigned short bf16_t;
typedef float f32x4 __attribute__((ext_vector_type(4)));
typedef unsigned u32x4 __attribute__((ext_vector_type(4)));
typedef unsigned u32x2 __attribute__((ext_vector_type(2)));

__device__ __forceinline__ float bf2f(unsigned short b) { return __uint_as_float(((unsigned)b) << 16); }
typedef float f32x2_t __attribute__((ext_vector_type(2))); typedef __bf16 bf16x2_t __attribute__((ext_vector_type(2)));
__device__ __forceinline__ unsigned pk2(float lo, float hi) { f32x2_t v = {lo, hi}; bf16x2_t b = __builtin_convertvector(v, bf16x2_t); return __builtin_bit_cast(unsigned, b); }
__device__ __forceinline__ float silu_f(float x) { return x / (1.f + __expf(-x)); }
__device__ __forceinline__ float wave_sum(float v) {
#pragma unroll
    for (int o = 1; o < 64; o <<= 1) v += __shfl_xor(v, o);
    return v;
}

#define XB_TMO      128
#define XB_XCNT(j)  (256  + 64 * (j))
#define XB_XSUB(j)  (1280 + 64 * (j))
#define XB_XGEN(j)  (2304 + 64 * (j))
#define XB_TOP      3328
#define XB_TOPGEN   3392
#define XCD_BAR_WORDS 3456
#define XB_SPIN_CAP (1u << 22)
__device__ __forceinline__ unsigned xb_ld(unsigned* p)              { return __hip_atomic_load(p, __ATOMIC_RELAXED, __HIP_MEMORY_SCOPE_AGENT); }
__device__ __forceinline__ unsigned xb_add(unsigned* p, unsigned v) { return __hip_atomic_fetch_add(p, v, __ATOMIC_RELAXED, __HIP_MEMORY_SCOPE_AGENT); }
__device__ __forceinline__ unsigned xb_xcc_id() { return (unsigned)__builtin_amdgcn_s_getreg((3 << 11) | 20) & 0xFu; }
#define XB_SPIN(cond, bar) do { unsigned _sp = 0; while (cond) { __builtin_amdgcn_s_sleep(1); \
    if ((++_sp & 255u) == 0u) { if (xb_ld(&(bar)[XB_TMO])) break; if (_sp > XB_SPIN_CAP) { atomicAdd(&(bar)[XB_TMO], 1u); break; } } } } while (0)
struct XcdBarrier { unsigned* bar; unsigned x; volatile LAS unsigned* st; };
__device__ __forceinline__ XcdBarrier xcd_barrier_post(unsigned* bar, volatile LAS unsigned* st) {
    XcdBarrier b; b.bar = bar; b.x = xb_xcc_id(); b.st = st;
    if (threadIdx.x == 0) (void)xb_add(&bar[XB_XCNT(b.x)], 1u);
    return b;
}
__device__ __forceinline__ void xcd_barrier_complete(unsigned* bar, unsigned x, unsigned& nloc, unsigned& nx) {
    const unsigned G = gridDim.x * gridDim.y * gridDim.z;
    unsigned sum, cnt, mine, sp = 0u;
    for (;;) {
        sum = 0u; cnt = 0u; mine = 0u;
#pragma unroll
        for (unsigned j = 0; j < 16; ++j) { const unsigned c = xb_ld(&bar[XB_XCNT(j)]); sum += c; cnt += (c > 0u) ? 1u : 0u; mine = (j == x) ? c : mine; }
        if (sum == G) break;
        __builtin_amdgcn_s_sleep(1);
        if ((++sp & 255u) == 0u) { if (xb_ld(&bar[XB_TMO])) break; if (sp > XB_SPIN_CAP) { atomicAdd(&bar[XB_TMO], 1u); break; } }
    }
    nloc = mine > 0u ? mine : 1u; nx = cnt > 0u ? cnt : 1u;
}
__device__ __forceinline__ void xcd_barrier(const XcdBarrier& b) {
    asm volatile("s_waitcnt vmcnt(0)" ::: "memory");
    __syncthreads();
    if (threadIdx.x == 0) {
        unsigned* bar = b.bar;
        __builtin_amdgcn_s_waitcnt(0);
        unsigned nloc = b.st[0], nx = b.st[1];
        if (nloc == 0u) { xcd_barrier_complete(bar, b.x, nloc, nx); b.st[0] = nloc; b.st[1] = nx; }
        const unsigned old = xb_add(&bar[XB_XSUB(b.x)], 1u);
        const unsigned gen = old / nloc;
        if (old + 1u == (gen + 1u) * nloc) {
            __builtin_amdgcn_fence(__ATOMIC_RELEASE, "agent");
            asm volatile("s_waitcnt vmcnt(0)" ::: "memory");
            const unsigned og = xb_add(&bar[XB_TOP], 1u);
            const unsigned tg = og / nx;
            if (og + 1u == (tg + 1u) * nx) xb_add(&bar[XB_TOPGEN], 1u);
            else XB_SPIN(xb_ld(&bar[XB_TOPGEN]) == tg, bar);
            __builtin_amdgcn_fence(__ATOMIC_ACQUIRE, "agent");
            xb_add(&bar[XB_XGEN(b.x)], 1u);
            asm volatile("s_waitcnt vmcnt(0)" ::: "memory");
        } else {
            XB_SPIN(xb_ld(&bar[XB_XGEN(b.x)]) == gen, bar);
            __builtin_amdgcn_fence(__ATOMIC_ACQUIRE, "agent");
            asm volatile("s_waitcnt vmcnt(0)" ::: "memory");
        }
    }
    __syncthreads();
}

using pg8::Unit;
struct EpiInProj {
    static constexpr bool PERM = true, AFTER_DRAIN = false;
    unsigned char* ws; const float* lb;
    template <int KIND> __device__ __forceinline__ void hg_part(const f32x4 (&acc)[2][2][4][2], bf16_t* dst, const float* lbp, int rbase, int cb) const {
#pragma unroll
        for (int bj = 0; bj < 2; ++bj) {
            const int cc = cb + bj * 128;
            f32x4 l0 = {0.f, 0.f, 0.f, 0.f}, l1 = {0.f, 0.f, 0.f, 0.f};
            if (KIND == 2) { l0 = *(const f32x4*)(lbp + cc); l1 = *(const f32x4*)(lbp + cc + 4); }
#pragma unroll
            for (int ai = 0; ai < 2; ++ai)
#pragma unroll
                for (int m = 0; m < 4; ++m) {
                    f32x4 v0 = acc[ai][bj][m][0], v1 = acc[ai][bj][m][1];
                    if (KIND == 1) {
#pragma unroll
                        for (int e = 0; e < 4; ++e) { v0[e] = silu_f(v0[e]); v1[e] = silu_f(v1[e]); }
                    } else if (KIND == 2) {
#pragma unroll
                        for (int e = 0; e < 4; ++e) {
                            const float f0 = l0[e] + (1.f - l0[e]) / (1.f + __expf(-v0[e])); v0[e] = __logf(f0);
                            const float f1 = l1[e] + (1.f - l1[e]) / (1.f + __expf(-v1[e])); v1[e] = __logf(f1);
                        }
                    }
                    u32x4 w; w.x = pk2(v0[0], v0[1]); w.y = pk2(v0[2], v0[3]); w.z = pk2(v1[0], v1[1]); w.w = pk2(v1[2], v1[3]);
                    *(u32x4*)(dst + (size_t)(rbase + ai * 128 + m * 16) * 512 + cc) = w;
                }
        }
    }
    __device__ __forceinline__ void operator()(const f32x4 (&acc)[2][2][4][2], const Unit& u, int wr, int wc, int fr_, int fq_) const {
        int fr = fr_, fq = fq_; asm volatile("" : "+v"(fr), "+v"(fq));
        const int pn = u.pn;
        const int rbase = u.pm * 256 + wr * 64 + fr;
        const int cl = wc * 32 + 8 * fq;
        if (pn < 10) {
            const int kind = pn >> 1, cb = (pn & 1) * 256 + cl;
            bf16_t* dst = (bf16_t*)(ws + WS_PQ + (size_t)kind * PSTRIDE);
            if (kind == 0 || kind == 2) hg_part<1>(acc, dst, lb, rbase, cb);
            else if (kind == 1) hg_part<0>(acc, dst, lb, rbase, cb);
            else hg_part<2>(acc, dst, lb + (kind - 3) * 512, rbase, cb);
        } else if (pn <= 11) {
            const bool isq = (pn == 10);
            bf16_t* dst = (bf16_t*)(ws + (isq ? WS_AQ : WS_AK));
            const float sc = isq ? QSCALE : 1.f;
            const bool lat = u.pm < 64;
            const float sgn = (fq & 1) ? 1.f : -1.f;
            const float* rc = (const float*)(ws + WS_TAB + TAB_ROPEC);
            const float* rs = (const float*)(ws + WS_TAB + TAB_ROPES);
#pragma unroll
            for (int ai = 0; ai < 2; ++ai)
#pragma unroll
                for (int m = 0; m < 4; ++m) {
                    const int row = rbase + ai * 128 + m * 16;
                    size_t orow;
                    if (isq) orow = (size_t)row;
                    else orow = lat ? (size_t)((row >> 12) * KEYS + (row & 4095)) : (size_t)(((row - ML) >> 8) * KEYS + SEQ + ((row - ML) & 255));
                    f32x4 c0 = {1.f, 1.f, 1.f, 1.f}, c1 = c0, s0 = {0.f, 0.f, 0.f, 0.f}, s1 = s0;
                    if (lat) { const int t = row & 4095, pos = (fq < 2) ? (t >> 6) : (t & 63);
                        c0 = *(const f32x4*)(rc + pos * 8); c1 = *(const f32x4*)(rc + pos * 8 + 4); s0 = *(const f32x4*)(rs + pos * 8); s1 = *(const f32x4*)(rs + pos * 8 + 4); }
#pragma unroll
                    for (int bj = 0; bj < 2; ++bj) {
                        f32x4 v0 = acc[ai][bj][m][0], v1 = acc[ai][bj][m][1];
                        if (lat) {
                            f32x4 p0, p1;
#pragma unroll
                            for (int e = 0; e < 4; ++e) { p0[e] = __shfl_xor(v0[e], 16); p1[e] = __shfl_xor(v1[e], 16); }
                            v0 = v0 * c0 + (p0 * s0) * sgn; v1 = v1 * c1 + (p1 * s1) * sgn;
                        }
                        v0 = v0 * sc; v1 = v1 * sc;
                        u32x4 w; w.x = pk2(v0[0], v0[1]); w.y = pk2(v0[2], v0[3]); w.z = pk2(v1[0], v1[1]); w.w = pk2(v1[2], v1[3]);
                        *(u32x4*)(dst + orow * 256 + cl + bj * 128) = w;
                    }
                }
        } else if (pn == 12) {
            bf16_t* dst = (bf16_t*)(ws + WS_AV);
            const bool lat = u.pm < 64;
#pragma unroll
            for (int ai = 0; ai < 2; ++ai)
#pragma unroll
                for (int m = 0; m < 4; ++m) {
                    const int row = rbase + ai * 128 + m * 16;
                    const size_t orow = lat ? (size_t)((row >> 12) * KEYS + (row & 4095)) : (size_t)(((row - ML) >> 8) * KEYS + SEQ + ((row - ML) & 255));
#pragma unroll
                    for (int bj = 0; bj < 2; ++bj) {
                        const f32x4 v0 = acc[ai][bj][m][0], v1 = acc[ai][bj][m][1];
                        u32x4 w; w.x = pk2(v0[0], v0[1]); w.y = pk2(v0[2], v0[3]); w.z = pk2(v1[0], v1[1]); w.w = pk2(v1[2], v1[3]);
                        *(u32x4*)(dst + orow * 256 + cl + bj * 128) = w;
                    }
                }
        } else {
            const int is_s = pn - 13;
            const bool lat = u.pm < 64;
            const unsigned cs2 = lat ? 8192u * 2u : 512u * 2u;
            __amdgpu_buffer_rsrc_t rs = __builtin_amdgcn_make_buffer_rsrc((void*)(ws + (lat ? WS_BTL : WS_BTC)), 0, lat ? (int)(NB * 256 * 8192 * 2) : (int)(NB * 256 * 512 * 2), 0x00020000);
#pragma unroll
            for (int ai = 0; ai < 2; ++ai)
#pragma unroll
                for (int m = 0; m < 4; ++m) {
                    const int row = rbase + ai * 128 + m * 16;
                    unsigned voff;
                    if (lat) voff = ((unsigned)(row >> 12) * 256u * 8192u + (unsigned)is_s * 4096u + (unsigned)(row & 4095)) * 2u + (unsigned)cl * cs2;
                    else { const int rr = row - ML; voff = ((unsigned)(rr >> 8) * 256u * 512u + (unsigned)is_s * 256u + (unsigned)(rr & 255)) * 2u + (unsigned)cl * cs2; }
#pragma unroll
                    for (int bj = 0; bj < 2; ++bj)
#pragma unroll
                        for (int n = 0; n < 2; ++n) {
                            const f32x4 v = acc[ai][bj][m][n];
#pragma unroll
                            for (int e = 0; e < 4; ++e)
                                __builtin_amdgcn_raw_buffer_store_b16((unsigned short)(pk2(v[e], 0.f) & 0xffffu), rs, (int)voff, (int)((unsigned)(bj * 128 + 4 * n + e) * cs2), 0);
                        }
                    asm volatile("" ::: "memory");
                }
        }
    }
};
struct EpiF32 {
    static constexpr bool PERM = false, AFTER_DRAIN = false;
    float* Y; int ldc;
    __device__ __forceinline__ void operator()(const f32x4 (&acc)[2][2][4][2], const Unit& u, int wr, int wc, int fr_, int fq_) const {
        int fr = fr_, fq = fq_; asm volatile("" : "+v"(fr), "+v"(fq));
        const int row0 = u.pm * 256 + wr * 64 + fr, col0 = u.pn * 256 + wc * 32 + 4 * fq;
#pragma unroll
        for (int ai = 0; ai < 2; ++ai)
#pragma unroll
            for (int m = 0; m < 4; ++m) { float* rp = Y + (size_t)(row0 + ai * 128 + m * 16) * ldc + col0;
#pragma unroll
                for (int bj = 0; bj < 2; ++bj)
#pragma unroll
                    for (int n = 0; n < 2; ++n) *(f32x4*)(rp + bj * 128 + n * 16) = acc[ai][bj][m][n]; }
    }
};
struct EpiSwiGLU {
    static constexpr bool PERM = true, AFTER_DRAIN = false;
    bf16_t* ACT;
    __device__ __forceinline__ void operator()(const f32x4 (&acc)[2][2][4][2], const Unit& u, int wr, int wc, int fr_, int fq_) const {
        int fr = fr_, fq = fq_; asm volatile("" : "+v"(fr), "+v"(fq));
        const int row0 = u.pm * 256 + wr * 64 + fr, col0 = u.pn * 128 + wc * 32 + 8 * fq;
#pragma unroll
        for (int ai = 0; ai < 2; ++ai)
#pragma unroll
            for (int m = 0; m < 4; ++m) {
                f32x4 g0 = acc[ai][0][m][0], g1 = acc[ai][0][m][1]; const f32x4 u0 = acc[ai][1][m][0], u1 = acc[ai][1][m][1];
#pragma unroll
                for (int e = 0; e < 4; ++e) { g0[e] = silu_f(g0[e]) * u0[e]; g1[e] = silu_f(g1[e]) * u1[e]; }
                u32x4 w; w.x = pk2(g0[0], g0[1]); w.y = pk2(g0[2], g0[3]); w.z = pk2(g1[0], g1[1]); w.w = pk2(g1[2], g1[3]);
                *(u32x4*)(ACT + (size_t)(row0 + ai * 128 + m * 16) * FFH + col0) = w;
            }
    }
};
struct EpiDft {
    static constexpr bool PERM = true, AFTER_DRAIN = false;
    bf16_t* MIX; int ctx;
    __device__ __forceinline__ void operator()(const f32x4 (&acc)[2][2][4][2], const Unit& u, int wr, int wc, int fr_, int fq_) const {
        int fr = fr_, fq = fq_; asm volatile("" : "+v"(fr), "+v"(fq));
        const int rowb = (ctx ? ML + u.pn * CTX : u.pn * SEQ + u.pm * 256) + wr * 64 + fr, col0 = 768 + wc * 32 + 8 * fq;
#pragma unroll
        for (int ai = 0; ai < 2; ++ai)
#pragma unroll
            for (int m = 0; m < 4; ++m)
#pragma unroll
                for (int bj = 0; bj < 2; ++bj) {
                    const f32x4 v0 = acc[ai][bj][m][0], v1 = acc[ai][bj][m][1];
                    u32x4 w; w.x = pk2(v0[0], v0[1]); w.y = pk2(v0[2], v0[3]); w.z = pk2(v1[0], v1[1]); w.w = pk2(v1[2], v1[3]);
                    *(u32x4*)(MIX + (size_t)(rowb + ai * 128 + m * 16) * DM + col0 + bj * 128) = w;
                }
    }
};
struct DftOrder {
    int G, c, off, n, npm;
    __device__ __forceinline__ bool next(int i, Unit& u) const { const int L = i * G + c - off; if (L < 0 || L >= n) return false; u.pm = L % npm; u.pn = L / npm; return true; }
    __device__ __forceinline__ void a_ready(const Unit&) const {}
    __device__ __forceinline__ void done(const Unit&) const {}
};

__device__ __forceinline__ void transpose_item(const float* W, int K, int Nsrc, bf16_t* WT, int dst_row0, int src_col0, int kb, LAS float* scr, int lane) {
    const int k0 = 64 * kb;
#pragma unroll 8
    for (int i = 0; i < 32; ++i) { const int kk = 2 * i + (lane >> 5); scr[kk * 33 + (lane & 31)] = W[(size_t)(k0 + kk) * Nsrc + src_col0 + (lane & 31)]; }
    asm volatile("s_waitcnt lgkmcnt(0)" ::: "memory");
    const int c = lane & 7;
#pragma unroll
    for (int j = 0; j < 4; ++j) { const int n = (lane >> 3) + 8 * j; const LAS float* s = scr + (8 * c) * 33 + n;
        u32x4 o; o.x = pk2(s[0 * 33], s[1 * 33]); o.y = pk2(s[2 * 33], s[3 * 33]); o.z = pk2(s[4 * 33], s[5 * 33]); o.w = pk2(s[6 * 33], s[7 * 33]);
        *(u32x4*)(WT + (size_t)(dst_row0 + n) * K + k0 + 8 * c) = o; }
    asm volatile("s_waitcnt lgkmcnt(0)" ::: "memory");
}
__device__ __forceinline__ void convert_weights(const float* const* in, unsigned char* ws, int layer, LAS unsigned char* lds, int wave, int lane, int gw, int NGW) {
    LAS float* scr = (LAS float*)(lds + wave * 16384);
    const float* w_in = in[0] + (size_t)layer * DM * INW;
    const float* w_out = in[1] + (size_t)layer * DM * DM;
    const float* w_fi = in[2] + (size_t)layer * DM * 2 * FFH;
    const float* w_fo = in[3] + (size_t)layer * FFH * DM;
    bf16_t* WIN = (bf16_t*)(ws + WS_WIN); bf16_t* WOUT = (bf16_t*)(ws + WS_WOUT); bf16_t* WFI = (bf16_t*)(ws + WS_WFI); bf16_t* WFO = (bf16_t*)(ws + WS_WFO);
    constexpr int I_IN = 16 * 104, I_OUT = 16 * 32, I_FI = 16 * 176, I_FO = 44 * 32, I_FOLD = 4096;
    constexpr int NIT = I_IN + I_OUT + I_FI + I_FO + I_FOLD;
    for (int it = gw; it < NIT; it += NGW) {
        int r = it;
        if (r < I_IN) { const int kb = r / 104, nb = r % 104; transpose_item(w_in, DM, INW, WIN, 32 * nb, 32 * nb, kb, scr, lane); continue; } r -= I_IN;
        if (r < I_OUT) { const int kb = r / 32, nb = r % 32; transpose_item(w_out, DM, DM, WOUT, 32 * nb, 32 * nb, kb, scr, lane); continue; } r -= I_OUT;
        if (r < I_FI) { const int kb = r / 176, nb = r % 176; const int tile = nb >> 3, wi = nb & 7;
            const int src = (wi < 4) ? (128 * tile + 32 * wi) : (FFH + 128 * tile + 32 * (wi - 4));
            transpose_item(w_fi, DM, 2 * FFH, WFI, 32 * nb, src, kb, scr, lane); continue; } r -= I_FI;
        if (r < I_FO) { const int kb = r / 32, nb = r % 32; transpose_item(w_fo, FFH, DM, WFO, 32 * nb, 32 * nb, kb, scr, lane); continue; } r -= I_FO;
        {
            const int k = r >> 2, g = r & 3;
            const float w = w_in[(size_t)k * INW + 3328 + g * 64 + lane] * 0.125f;
            float myc = 0.f, mys = 0.f;
            for (int k2 = 0; k2 < 64; ++k2) {
                const int ph = (lane * k2) & 63;
                const float cv = cospif((float)ph * (1.f / 32.f)), sv = sinpif((float)ph * (1.f / 32.f));
                const float a = wave_sum(w * cv), b = wave_sum(w * sv);
                if (lane == k2) { myc = a; mys = b; }
            }
            WIN[(size_t)(3328 + g * 64 + lane) * DM + k] = (bf16_t)(pk2(myc, 0.f) & 0xffffu);
            WIN[(size_t)(3584 + g * 64 + lane) * DM + k] = (bf16_t)(pk2(mys, 0.f) & 0xffffu);
        }
    }
}

__device__ __forceinline__ void row_update(const float* xin, const float* y, const float* gate, const float* gy, float* xout,
                                           const float* gh, const float* shift, const float* scale, bf16_t* hout, int lane) {
    f32x4 xv[4];
#pragma unroll
    for (int j = 0; j < 4; ++j) xv[j] = *(const f32x4*)(xin + 4 * lane + 256 * j);
    if (y) {
        f32x4 yv[4]; float ss = 0.f;
#pragma unroll
        for (int j = 0; j < 4; ++j) { yv[j] = *(const f32x4*)(y + 4 * lane + 256 * j); ss += (yv[j][0] * yv[j][0] + yv[j][1] * yv[j][1]) + (yv[j][2] * yv[j][2] + yv[j][3] * yv[j][3]); }
        const float rstd = rsqrtf(wave_sum(ss) * (1.f / DM) + EPS);
#pragma unroll
        for (int j = 0; j < 4; ++j) { const f32x4 gt = *(const f32x4*)(gate + 4 * lane + 256 * j), gg = *(const f32x4*)(gy + 4 * lane + 256 * j);
            xv[j] = xv[j] + gt * ((yv[j] * rstd) * gg); *(f32x4*)(xout + 4 * lane + 256 * j) = xv[j]; }
    }
    if (hout) {
        float ss = 0.f;
#pragma unroll
        for (int j = 0; j < 4; ++j) ss += (xv[j][0] * xv[j][0] + xv[j][1] * xv[j][1]) + (xv[j][2] * xv[j][2] + xv[j][3] * xv[j][3]);
        const float rstd = rsqrtf(wave_sum(ss) * (1.f / DM) + EPS);
#pragma unroll
        for (int j = 0; j < 4; ++j) { const f32x4 gg = *(const f32x4*)(gh + 4 * lane + 256 * j), sh = *(const f32x4*)(shift + 4 * lane + 256 * j), sc = *(const f32x4*)(scale + 4 * lane + 256 * j);
            const f32x4 hv = ((xv[j] * rstd) * gg) * (sc + 1.f) + sh;
            u32x2 w; w.x = pk2(hv[0], hv[1]); w.y = pk2(hv[2], hv[3]); *(u32x2*)(hout + 4 * lane + 256 * j) = w; }
    }
}

typedef short bf16x8 __attribute__((ext_vector_type(8)));
typedef float f32x16 __attribute__((ext_vector_type(16)));
typedef short s16x4 __attribute__((ext_vector_type(4)));
typedef short v4i16_t __attribute__((ext_vector_type(4)));
constexpr int ATT_BUF = 16384;
constexpr int ATT_WSF = 2 * ATT_BUF;
constexpr float ATT_THR = 8.0f;
__device__ __forceinline__ int crow16(int r, int hi) { return (r & 3) + 8 * (r >> 2) + 4 * hi; }
__device__ __forceinline__ s16x4 lds_tr(LAS const unsigned char* p) { return __builtin_bit_cast(s16x4, __builtin_amdgcn_ds_read_tr16_b64_v4i16((LAS v4i16_t*)p)); }

__device__ __forceinline__ void attn_unit(unsigned char* ws, LAS unsigned char* lds, int b, int h, int qrow0, int key0, int ntiles, float lam, float outscale, const float* subln) {
    const int tid = opaque_tid(), lane = tid & 63, r32 = lane & 31, hh = lane >> 5;
    const int wave = __builtin_amdgcn_readfirstlane(tid >> 6);
    const bf16_t* AQ = (const bf16_t*)(ws + WS_AQ); const bf16_t* AK = (const bf16_t*)(ws + WS_AK); const bf16_t* AV = (const bf16_t*)(ws + WS_AV);
    bf16_t* MIX = (bf16_t*)(ws + WS_H);
    bf16x8 qf[2][2];
    {
        const bf16_t* qp = AQ + (size_t)(qrow0 + wave * 32 + r32) * 256 + h * 64 + hh * 8;
#pragma unroll
        for (int mp = 0; mp < 2; ++mp)
#pragma unroll
            for (int s = 0; s < 2; ++s) qf[mp][s] = *(const bf16x8*)(qp + mp * 32 + s * 16);
    }
    f32x16 O[2][2];
#pragma unroll
    for (int mp = 0; mp < 2; ++mp)
#pragma unroll
        for (int nb = 0; nb < 2; ++nb)
#pragma unroll
            for (int r = 0; r < 16; ++r) O[mp][nb][r] = 0.f;
    float mref[2] = {-1e30f, -1e30f}, lsum[2] = {0.f, 0.f};
    const int skey = tid >> 3, sch = tid & 7;
    const size_t gsrc = (size_t)(b * KEYS + key0 + skey) * 256 + h * 64 + sch * 8;
    const int kdst = skey * 128 + ((sch ^ ((skey >> 1) & 7)) << 4);
    const int vdst = 8192 + (sch >> 2) * 4096 + skey * 64 + (sch & 3) * 16;
    LAS float* wsf = (LAS float*)(lds + ATT_WSF + wave * 256);
    u32x4 kreg = *(const u32x4*)(AK + gsrc), vreg = *(const u32x4*)(AV + gsrc);
    *(LAS u32x4*)(lds + kdst) = kreg; *(LAS u32x4*)(lds + vdst) = vreg;
    __syncthreads();
    const int koff = r32 * 128;
    const int kswz = (r32 >> 1) & 7;
    const int voff = 8192 + (4 * hh + ((lane & 15) >> 2)) * 64 + ((lane >> 4) & 1) * 32 + (lane & 3) * 8;
    for (int kt = 0; kt < ntiles; ++kt) {
        const bool more = (kt + 1 < ntiles);
        if (more) { kreg = *(const u32x4*)(AK + gsrc + (size_t)(kt + 1) * 64 * 256); vreg = *(const u32x4*)(AV + gsrc + (size_t)(kt + 1) * 64 * 256); }
        LAS const unsigned char* buf = lds + (kt & 1) * ATT_BUF;
        bf16x8 pf[2][2][2];
#pragma unroll
        for (int mp = 0; mp < 2; ++mp) {
            f32x16 S[2];
#pragma unroll
            for (int kb = 0; kb < 2; ++kb) {
#pragma unroll
                for (int r = 0; r < 16; ++r) S[kb][r] = 0.f;
#pragma unroll
                for (int s = 0; s < 2; ++s) {
                    const int ch = mp * 4 + s * 2 + hh;
                    const bf16x8 kf = *(LAS const bf16x8*)(buf + kb * 4096 + koff + ((ch ^ kswz) << 4));
                    S[kb] = __builtin_amdgcn_mfma_f32_32x32x16_bf16(kf, qf[mp][s], S[kb], 0, 0, 0);
                }
            }
            float rm = fmaxf(S[0][0], S[1][0]);
#pragma unroll
            for (int r = 1; r < 16; ++r) rm = fmaxf(rm, fmaxf(S[0][r], S[1][r]));
            rm = fmaxf(rm, __shfl_xor(rm, 32));
            const bool need = rm > mref[mp] + ATT_THR;
            if (__any(need)) {
                const float mn = need ? rm : mref[mp];
                const float al = __builtin_amdgcn_exp2f(mref[mp] - mn);
                mref[mp] = mn; lsum[mp] *= al;
                if (hh == 0) wsf[r32] = al;
                asm volatile("s_waitcnt lgkmcnt(0)" ::: "memory");
#pragma unroll
                for (int r = 0; r < 16; ++r) { const float a = wsf[crow16(r, hh)]; O[mp][0][r] *= a; O[mp][1][r] *= a; }
                asm volatile("s_waitcnt lgkmcnt(0)" ::: "memory");
            }
            const float mm = mref[mp];
            float ps = 0.f;
#pragma unroll
            for (int kb = 0; kb < 2; ++kb) {
#pragma unroll
                for (int r = 0; r < 16; ++r) { const float p = __builtin_amdgcn_exp2f(S[kb][r] - mm); S[kb][r] = p; ps += p; }
#pragma unroll
                for (int s = 0; s < 2; ++s) {
                    u32x4 w; w.x = pk2(S[kb][8 * s + 0], S[kb][8 * s + 1]); w.y = pk2(S[kb][8 * s + 2], S[kb][8 * s + 3]);
                    w.z = pk2(S[kb][8 * s + 4], S[kb][8 * s + 5]); w.w = pk2(S[kb][8 * s + 6], S[kb][8 * s + 7]);
                    pf[mp][kb][s] = __builtin_bit_cast(bf16x8, w);
                }
            }
            lsum[mp] += ps;
        }
#pragma unroll
        for (int kb = 0; kb < 2; ++kb)
#pragma unroll
            for (int s = 0; s < 2; ++s)
#pragma unroll
                for (int nb = 0; nb < 2; ++nb) {
                    LAS const unsigned char* vp = buf + voff + nb * 4096 + (kb * 32 + s * 16) * 64;
                    const s16x4 lo = lds_tr(vp), hi = lds_tr(vp + 8 * 64);
                    const bf16x8 vf = (bf16x8){lo[0], lo[1], lo[2], lo[3], hi[0], hi[1], hi[2], hi[3]};
                    O[0][nb] = __builtin_amdgcn_mfma_f32_32x32x16_bf16(pf[0][kb][s], vf, O[0][nb], 0, 0, 0);
                    O[1][nb] = __builtin_amdgcn_mfma_f32_32x32x16_bf16(pf[1][kb][s], vf, O[1][nb], 0, 0, 0);
                }
        if (more) { LAS unsigned char* nb_ = lds + ((kt + 1) & 1) * ATT_BUF; *(LAS u32x4*)(nb_ + kdst) = kreg; *(LAS u32x4*)(nb_ + vdst) = vreg; }
        __syncthreads();
    }
    {
        const float l0 = lsum[0] + __shfl_xor(lsum[0], 32), l1 = lsum[1] + __shfl_xor(lsum[1], 32);
        if (hh == 0) { wsf[r32] = 1.f / l0; wsf[32 + r32] = lam / l1; }
        asm volatile("s_waitcnt lgkmcnt(0)" ::: "memory");
        const float g0 = subln[r32] * outscale, g1 = subln[32 + r32] * outscale;
        bf16_t* op = MIX + (size_t)(qrow0 + wave * 32) * DM + 512 + h * 64 + r32;
#pragma unroll
        for (int r = 0; r < 16; ++r) {
            const int q = crow16(r, hh);
            const float i0 = wsf[q], i1 = wsf[32 + q];
            const float a = O[0][0][r] * i0 - O[1][0][r] * i1, c = O[0][1][r] * i0 - O[1][1][r] * i1;
            float ss = a * a + c * c;
            ss += __shfl_xor(ss, 1); ss += __shfl_xor(ss, 2); ss += __shfl_xor(ss, 4); ss += __shfl_xor(ss, 8); ss += __shfl_xor(ss, 16);
            const float rstd = rsqrtf(ss * (1.f / 64.f) + EPS);
            op[(size_t)q * DM] = (bf16_t)(pk2(a * rstd * g0, 0.f) & 0xffffu);
            op[(size_t)q * DM + 32] = (bf16_t)(pk2(c * rstd * g1, 0.f) & 0xffffu);
        }
        asm volatile("s_waitcnt lgkmcnt(0)" ::: "memory");
    }
    __syncthreads();
}
typedef float f32x4_t __attribute__((ext_vector_type(4)));
constexpr int HG_ITEMS = 1088;
constexpr size_t WS_KD = WS_BTC + 1 * MiB;
constexpr size_t WS_VT = WS_KD + 34 * MiB;
constexpr size_t WS_VEC = WS_VT + 17 * MiB;
constexpr size_t WS_OX = WS_VEC + 4 * MiB;
static_assert(WS_OX + 34 * MiB <= 384 * MiB, "ws map (hgrn)");
constexpr int P1_SQP = 0, P1_SKP = 17408, P1_SKT = 34816, P1_SVT = 53248, P1_SS = 71680, P1_SEG = 80896;
constexpr int QSTR = 272, TSTR = 144;

__device__ __forceinline__ void hg_pass1_item(unsigned char* ws, LAS unsigned char* lds, int item) {
    const int tid = opaque_tid(), lane = tid & 63, n16 = lane & 15, g4 = lane >> 4;
    const int wave = __builtin_amdgcn_readfirstlane(tid >> 6);
    int bh, row0;
    if (item < 1024) { bh = item >> 6; row0 = (bh >> 2) * SEQ + (item & 63) * 64; }
    else { const int i2 = item - 1024; bh = i2 >> 2; row0 = ML + (bh >> 2) * CTX + (i2 & 3) * 64; }
    const int h = bh & 3;
    bf16_t* P0 = (bf16_t*)(ws + WS_PQ);
    const size_t PS = PSTRIDE / 2;
    const int kp = lane, seg = wave;
    float q[8][2], gf[8][2], gb[8][2];
    {
        float v[8][2];
#pragma unroll
        for (int i = 0; i < 8; ++i) {
            const size_t off = (size_t)(row0 + 8 * seg + i) * 512 + h * 128 + 2 * kp;
            const unsigned uq = *(const unsigned*)(P0 + off), uv = *(const unsigned*)(P0 + PS + off), uf = *(const unsigned*)(P0 + 3 * PS + off), ub = *(const unsigned*)(P0 + 4 * PS + off);
            q[i][0] = __uint_as_float(uq << 16); q[i][1] = __uint_as_float(uq & 0xffff0000u);
            v[i][0] = __uint_as_float(uv << 16); v[i][1] = __uint_as_float(uv & 0xffff0000u);
            gf[i][0] = __uint_as_float(uf << 16); gf[i][1] = __uint_as_float(uf & 0xffff0000u);
            gb[i][0] = __uint_as_float(ub << 16); gb[i][1] = __uint_as_float(ub & 0xffff0000u);
        }
#pragma unroll
        for (int e = 0; e < 2; ++e)
#pragma unroll
            for (int i = 0; i < 8; i += 2) *(LAS unsigned*)(lds + P1_SVT + (2 * kp + e) * TSTR + (8 * seg + i) * 2) = pk2(v[i][e], v[i + 1][e]);
    }
#pragma unroll
    for (int dir = 0; dir < 2; ++dir) {
        float bc[8][2], tot[2];
#pragma unroll
        for (int e = 0; e < 2; ++e) {
            float run = 0.f;
            if (dir == 0) {
#pragma unroll
                for (int i = 0; i < 8; ++i) { run += gf[i][e]; bc[i][e] = run; }
            } else {
#pragma unroll
                for (int i = 7; i >= 0; --i) { run += gb[i][e]; bc[i][e] = run; }
            }
            tot[e] = run;
        }
        LAS float* sSeg = (LAS float*)(lds + P1_SEG);
        sSeg[seg * 128 + 2 * kp] = tot[0]; sSeg[seg * 128 + 2 * kp + 1] = tot[1];
        __syncthreads();
        float offs[2], rref[2], blast[2];
#pragma unroll
        for (int e = 0; e < 2; ++e) {
            float T[8];
#pragma unroll
            for (int s2 = 0; s2 < 8; ++s2) T[s2] = sSeg[s2 * 128 + 2 * kp + e];
            float o = 0.f;
#pragma unroll
            for (int s2 = 0; s2 < 8; ++s2) { const bool inc = (dir == 0) ? (s2 < seg) : (s2 > seg); o += inc ? T[s2] : 0.f; }
            const float lo = (T[0] + T[1]) + (T[2] + T[3]), hi = (T[4] + T[5]) + (T[6] + T[7]);
            offs[e] = o; rref[e] = (dir == 0) ? lo : hi; blast[e] = lo + hi;
        }
        float kk[8][2];
#pragma unroll
        for (int i = 0; i < 8; ++i) {
            float qp[2];
#pragma unroll
            for (int e = 0; e < 2; ++e) {
                const float bb = bc[i][e] + offs[e];
                const float gg = (dir == 0) ? gf[i][e] : gb[i][e];
                qp[e] = q[i][e] * __expf(fminf(bb - rref[e], 80.f));
                kk[i][e] = (1.f - __expf(gg)) * __expf(fminf(rref[e] - bb, 80.f));
            }
            const int t = 8 * seg + i;
            *(LAS unsigned*)(lds + P1_SQP + t * QSTR + 4 * kp) = pk2(qp[0], qp[1]);
            *(LAS unsigned*)(lds + P1_SKP + t * QSTR + 4 * kp) = pk2(kk[i][0], kk[i][1]);
        }
#pragma unroll
        for (int e = 0; e < 2; ++e)
#pragma unroll
            for (int i = 0; i < 8; i += 2) *(LAS unsigned*)(lds + P1_SKT + (2 * kp + e) * TSTR + (8 * seg + i) * 2) = pk2(kk[i][e], kk[i + 1][e]);
        if (seg == 0) {
            float* vec = (float*)(ws + WS_VEC) + (size_t)(dir * HG_ITEMS + item) * 384 + 2 * kp;
#pragma unroll
            for (int e = 0; e < 2; ++e) { vec[e] = __expf(rref[e]); vec[128 + e] = __expf(blast[e] - rref[e]); vec[256 + e] = __expf(blast[e]); }
        }
        __syncthreads();
        {
            const int mt = wave >> 1;
#pragma unroll
            for (int nn = 0; nn < 2; ++nn) {
                const int nt = 2 * (wave & 1) + nn;
                const bool skip = (dir == 0) ? (nt > mt) : (nt < mt);
                pg8::f32x4 acc = {0.f, 0.f, 0.f, 0.f};
                if (!skip) {
#pragma unroll
                    for (int ks = 0; ks < 4; ++ks) {
                        const bf16x8 a = *(LAS const bf16x8*)(lds + P1_SQP + (16 * mt + n16) * QSTR + (32 * ks + 8 * g4) * 2);
                        const bf16x8 bq = *(LAS const bf16x8*)(lds + P1_SKP + (16 * nt + n16) * QSTR + (32 * ks + 8 * g4) * 2);
                        acc = __builtin_amdgcn_mfma_f32_16x16x32_bf16(a, bq, acc, 0, 0, 0);
                    }
                }
#pragma unroll
                for (int r = 0; r < 4; ++r) {
                    const int t = 16 * mt + 4 * g4 + r, s = 16 * nt + n16;
                    const bool keep = !skip && ((dir == 0) ? (s <= t) : (s >= t));
                    *(LAS bf16_t*)(lds + P1_SS + t * TSTR + s * 2) = (bf16_t)(pk2(keep ? acc[r] : 0.f, 0.f) & 0xffffu);
                }
            }
        }
        {
            bf16_t* QD = P0 + (dir ? PS : 0);
            bf16_t* KD = (bf16_t*)(ws + WS_KD) + (size_t)(dir * HG_ITEMS + item) * 8192;
            bf16_t* VT = (bf16_t*)(ws + WS_VT) + (size_t)item * 8192;
#pragma unroll
            for (int j = 0; j < 2; ++j) {
                const int idx = tid * 2 + j;
                { const int row = idx >> 4, ch = idx & 15; *(u32x4*)(QD + (size_t)(row0 + row) * 512 + h * 128 + ch * 8) = *(LAS const u32x4*)(lds + P1_SQP + row * QSTR + ch * 16); }
                { const int row = idx >> 3, ch = idx & 7; *(u32x4*)(KD + row * 64 + ch * 8) = *(LAS const u32x4*)(lds + P1_SKT + row * TSTR + ch * 16);
                  if (dir == 0) *(u32x4*)(VT + row * 64 + ch * 8) = *(LAS const u32x4*)(lds + P1_SVT + row * TSTR + ch * 16); }
            }
        }
        __syncthreads();
        {
            bf16x8 bfr[2];
#pragma unroll
            for (int ks = 0; ks < 2; ++ks) bfr[ks] = *(LAS const bf16x8*)(lds + P1_SVT + (16 * wave + n16) * TSTR + (32 * ks + 8 * g4) * 2);
            bf16_t* OI = P0 + (3 + dir) * PS;
#pragma unroll
            for (int mt = 0; mt < 4; ++mt) {
                pg8::f32x4 acc = {0.f, 0.f, 0.f, 0.f};
#pragma unroll
                for (int ks = 0; ks < 2; ++ks) {
                    const bf16x8 a = *(LAS const bf16x8*)(lds + P1_SS + (16 * mt + n16) * TSTR + (32 * ks + 8 * g4) * 2);
                    acc = __builtin_amdgcn_mfma_f32_16x16x32_bf16(a, bfr[ks], acc, 0, 0, 0);
                }
#pragma unroll
                for (int r = 0; r < 4; ++r) OI[(size_t)(row0 + 16 * mt + 4 * g4 + r) * 512 + h * 128 + 16 * wave + n16] = (bf16_t)(pk2(acc[r], 0.f) & 0xffffu);
            }
        }
        __syncthreads();
    }
}

constexpr int P2_BUF = 37888, P2_Q = 0, P2_KT = 17408, P2_VEC = 35840;
__device__ __forceinline__ void hg_pass2_block(unsigned char* ws, LAS unsigned char* lds, int bh, int dir) {
    const int tid = opaque_tid(), lane = tid & 63, n16 = lane & 15, g4 = lane >> 4;
    const int wave = __builtin_amdgcn_readfirstlane(tid >> 6);
    const int b = bh >> 2, h = bh & 3;
    const bf16_t* QD = (const bf16_t*)(ws + WS_PQ) + (dir ? PSTRIDE / 2 : 0);
    const bf16_t* KDb = (const bf16_t*)(ws + WS_KD) + (size_t)dir * HG_ITEMS * 8192;
    const bf16_t* VTb = (const bf16_t*)(ws + WS_VT);
    const float* VECb = (const float*)(ws + WS_VEC) + (size_t)dir * HG_ITEMS * 384;
    bf16_t* OX = (bf16_t*)(ws + WS_OX) + (size_t)dir * MR * 512;
    float S[8][4];
#pragma unroll
    for (int mt = 0; mt < 8; ++mt)
#pragma unroll
        for (int r = 0; r < 4; ++r) S[mt][r] = 0.f;
    u32x4 rq[2], rk[2], rv; bf16x8 vfn[2];
#define P2_CHUNK(i, item, row0) do { if ((i) < 4) { const int c_ = dir ? 3 - (i) : (i); item = 1024 + bh * 4 + c_; row0 = ML + b * CTX + c_ * 64; } \
                                     else { const int c_ = dir ? 63 - ((i) - 4) : ((i) - 4); item = bh * 64 + c_; row0 = b * SEQ + c_ * 64; } } while (0)
#define P2_LOAD(i) do { int item_, row0_; P2_CHUNK(i, item_, row0_); \
        _Pragma("unroll") for (int j = 0; j < 2; ++j) { const int idx = tid * 2 + j; \
            rq[j] = *(const u32x4*)(QD + (size_t)(row0_ + (idx >> 4)) * 512 + h * 128 + (idx & 15) * 8); \
            rk[j] = *(const u32x4*)(KDb + (size_t)item_ * 8192 + (idx >> 3) * 64 + (idx & 7) * 8); } \
        if (tid < 96) rv = *(const u32x4*)(VECb + (size_t)item_ * 384 + tid * 4); \
        _Pragma("unroll") for (int ks = 0; ks < 2; ++ks) vfn[ks] = *(const bf16x8*)(VTb + (size_t)item_ * 8192 + (16 * wave + n16) * 64 + 32 * ks + 8 * g4); } while (0)
#define P2_WRITE(bufp) do { _Pragma("unroll") for (int j = 0; j < 2; ++j) { const int idx = tid * 2 + j; \
            *(LAS u32x4*)((bufp) + P2_Q + (idx >> 4) * QSTR + (idx & 15) * 16) = rq[j]; \
            *(LAS u32x4*)((bufp) + P2_KT + (idx >> 3) * TSTR + (idx & 7) * 16) = rk[j]; } \
        if (tid < 96) *(LAS u32x4*)((bufp) + P2_VEC + tid * 16) = rv; } while (0)
    P2_LOAD(0);
    P2_WRITE(lds);
    bf16x8 vf[2] = {vfn[0], vfn[1]};
    __syncthreads();
    for (int i = 0; i < 68; ++i) {
        const bool more = (i + 1 < 68);
        if (more) P2_LOAD(i + 1);
        int item, row0; P2_CHUNK(i, item, row0); (void)item;
        LAS const unsigned char* buf = lds + (i & 1) * P2_BUF;
        LAS const float* vec = (LAS const float*)(buf + P2_VEC);
        bf16x8 sb[4];
#pragma unroll
        for (int s = 0; s < 4; ++s) {
            const f32x4_t e0 = *(LAS const f32x4_t*)(vec + 16 * (2 * s) + 4 * g4), e1 = *(LAS const f32x4_t*)(vec + 16 * (2 * s + 1) + 4 * g4);
            u32x4 w; w.x = pk2(S[2 * s][0] * e0[0], S[2 * s][1] * e0[1]); w.y = pk2(S[2 * s][2] * e0[2], S[2 * s][3] * e0[3]);
            w.z = pk2(S[2 * s + 1][0] * e1[0], S[2 * s + 1][1] * e1[1]); w.w = pk2(S[2 * s + 1][2] * e1[2], S[2 * s + 1][3] * e1[3]);
            sb[s] = __builtin_bit_cast(bf16x8, w);
        }
#pragma unroll
        for (int mt = 0; mt < 4; ++mt) {
            pg8::f32x4 acc = {0.f, 0.f, 0.f, 0.f};
#pragma unroll
            for (int s = 0; s < 4; ++s) {
                LAS const unsigned char* ap = buf + P2_Q + (16 * mt + n16) * QSTR + (32 * s + 4 * g4) * 2;
                const u32x2 lo = *(LAS const u32x2*)ap, hi = *(LAS const u32x2*)(ap + 32);
                u32x4 aw; aw.x = lo.x; aw.y = lo.y; aw.z = hi.x; aw.w = hi.y;
                acc = __builtin_amdgcn_mfma_f32_16x16x32_bf16(__builtin_bit_cast(bf16x8, aw), sb[s], acc, 0, 0, 0);
            }
#pragma unroll
            for (int r = 0; r < 4; ++r) OX[(size_t)(row0 + 16 * mt + 4 * g4 + r) * 512 + h * 128 + 16 * wave + n16] = (bf16_t)(pk2(acc[r], 0.f) & 0xffffu);
        }
#pragma unroll
        for (int mt = 0; mt < 8; ++mt) {
            pg8::f32x4 kv = {0.f, 0.f, 0.f, 0.f};
#pragma unroll
            for (int ks = 0; ks < 2; ++ks) {
                const bf16x8 a = *(LAS const bf16x8*)(buf + P2_KT + (16 * mt + n16) * TSTR + (32 * ks + 8 * g4) * 2);
                kv = __builtin_amdgcn_mfma_f32_16x16x32_bf16(a, vf[ks], kv, 0, 0, 0);
            }
            const f32x4_t eb = *(LAS const f32x4_t*)(vec + 128 + 16 * mt + 4 * g4), dc = *(LAS const f32x4_t*)(vec + 256 + 16 * mt + 4 * g4);
#pragma unroll
            for (int r = 0; r < 4; ++r) S[mt][r] = dc[r] * S[mt][r] + eb[r] * kv[r];
        }
        if (more) { P2_WRITE(lds + ((i + 1) & 1) * P2_BUF); vf[0] = vfn[0]; vf[1] = vfn[1]; }
        __syncthreads();
    }
#undef P2_CHUNK
#undef P2_LOAD
#undef P2_WRITE
}

__device__ __forceinline__ void hg_combine_row(unsigned char* ws, int row, const float* onorm, int lane) {
    const bf16_t* P0 = (const bf16_t*)(ws + WS_PQ); const size_t PS = PSTRIDE / 2;
    const bf16_t* OX = (const bf16_t*)(ws + WS_OX);
    const size_t off = (size_t)row * 512 + lane * 8;
    const u32x4 a = *(const u32x4*)(P0 + 3 * PS + off), b = *(const u32x4*)(P0 + 4 * PS + off), c = *(const u32x4*)(OX + off), d = *(const u32x4*)(OX + (size_t)MR * 512 + off);
    const u32x4 gg = *(const u32x4*)(P0 + 2 * PS + off);
    float o[8]; float ss = 0.f;
#pragma unroll
    for (int e = 0; e < 4; ++e) {
        o[2 * e] = (__uint_as_float(a[e] << 16) + __uint_as_float(b[e] << 16)) + (__uint_as_float(c[e] << 16) + __uint_as_float(d[e] << 16));
        o[2 * e + 1] = (__uint_as_float(a[e] & 0xffff0000u) + __uint_as_float(b[e] & 0xffff0000u)) + (__uint_as_float(c[e] & 0xffff0000u) + __uint_as_float(d[e] & 0xffff0000u));
        ss += o[2 * e] * o[2 * e] + o[2 * e + 1] * o[2 * e + 1];
    }
    ss += __shfl_xor(ss, 1); ss += __shfl_xor(ss, 2); ss += __shfl_xor(ss, 4); ss += __shfl_xor(ss, 8);
    const float rstd = rsqrtf(ss * (1.f / 128.f) + EPS);
    const float* on = onorm + (lane & 15) * 8;
    u32x4 w;
#pragma unroll
    for (int e = 0; e < 4; ++e) {
        const float g0 = __uint_as_float(gg[e] << 16), g1 = __uint_as_float(gg[e] & 0xffff0000u);
        w[e] = pk2(o[2 * e] * rstd * on[2 * e] * g0, o[2 * e + 1] * rstd * on[2 * e + 1] * g1);
    }
    *(u32x4*)((bf16_t*)(ws + WS_H) + (size_t)row * DM + lane * 8) = w;
}
struct Args { const float* in[15]; float* out; unsigned char* ws; int ph_lo, ph_hi; };
constexpr int PPL = 9;
constexpr int NPHASE = 2 + PPL * DEPTH;
typedef __attribute__((address_space(4))) const Args* cargs_t;
__device__ __forceinline__ cargs_t get_args() { __attribute__((address_space(4))) const void* p = (__attribute__((address_space(4))) const void*)__builtin_amdgcn_kernarg_segment_ptr(); asm volatile("" : "+s"(p) :: "memory"); return (cargs_t)p; }

__device__ __forceinline__ void phase_tables(cargs_t ap, int tid) {
    unsigned char* ws = ap->ws;
    const float* lb_logits = ap->in[9]; const float* da_lambda = ap->in[11];
    float* tab = (float*)(ws + WS_TAB);
    {
        const int pos = tid >> 3, f = tid & 7;
        const float inv_freq = 1.0f / powf(10000.0f, (float)(2 * f) / 16.0f);
        const float ang = (float)pos * inv_freq;
        tab[TAB_ROPEC / 4 + tid] = cosf(ang); tab[TAB_ROPES / 4 + tid] = sinf(ang);
    }
    if (tid < DEPTH) {
        const float* dl = da_lambda + tid * 4 * 32; float s01 = 0.f, s23 = 0.f;
        for (int d = 0; d < 32; ++d) { s01 += dl[d] * dl[32 + d]; s23 += dl[64 + d] * dl[96 + d]; }
        tab[TAB_LAM / 4 + tid] = expf(s01) - expf(s23) + (0.8f - 0.6f * expf(-0.3f * (float)tid));
    }
    for (int i = tid; i < 2 * 512; i += NTHREADS) {
        const int dir = i >> 9, ch = i & 511; float lg[DEPTH], mx = -1e30f;
#pragma unroll
        for (int l = 0; l < DEPTH; ++l) { lg[l] = lb_logits[(size_t)(dir * DEPTH + l) * 512 + ch]; mx = fmaxf(mx, lg[l]); }
        float den = 0.f;
#pragma unroll
        for (int l = 0; l < DEPTH; ++l) { lg[l] = expf(lg[l] - mx); den += lg[l]; }
        float cum = 0.f;
#pragma unroll
        for (int l = 0; l < DEPTH; ++l) { if (l > 0) cum += lg[l] / den; tab[TAB_LB / 4 + (l * 2 + dir) * 512 + ch] = cum; }
    }
}
__device__ __forceinline__ void phase_mod(cargs_t ap, float* smf, int tid, int bid, int G) {
    const float* c_in = ap->in[1]; const float* cctx_in = ap->in[3]; const float* w_mod = ap->in[4]; const float* b_mod = ap->in[5];
    float* MOD = (float*)(ap->ws + WS_MOD);
    float* sc = smf;
    float* red = smf + 5 * 1024;
    for (int i = tid; i < 5 * 1024; i += NTHREADS) { const int id = i >> 10, k = i & 1023; const float cv = (id < 4) ? c_in[id * 1024 + k] : cctx_in[k]; sc[i] = silu_f(cv); }
    __syncthreads();
    for (int it = bid; it < DEPTH * 96; it += G) {
        const int l = it / 96, jb = it % 96, ks = tid >> 6, j = tid & 63;
        const float* wp = w_mod + ((size_t)l * DM + ks * 128) * (NMOD * DM) + jb * 64 + j;
        float a[5] = {0.f, 0.f, 0.f, 0.f, 0.f};
        for (int k = 0; k < 128; ++k) { const float w = wp[(size_t)k * (NMOD * DM)];
#pragma unroll
            for (int id = 0; id < 5; ++id) a[id] += sc[id * 1024 + ks * 128 + k] * w; }
#pragma unroll
        for (int id = 0; id < 5; ++id) red[(ks * 5 + id) * 64 + j] = a[id];
        __syncthreads();
        if (tid < 5 * 64) { const int id = tid >> 6, jj = tid & 63; float s = b_mod[(size_t)l * NMOD * DM + jb * 64 + jj];
            for (int k2 = 0; k2 < 8; ++k2) s += red[(k2 * 5 + id) * 64 + jj];
            MOD[((size_t)l * 5 + id) * (NMOD * DM) + jb * 64 + jj] = s; }
        __syncthreads();
    }
}
__device__ __forceinline__ void phase_dftmat(cargs_t ap, float* smf, int tid, int bid, int G) {
    unsigned char* ws = ap->ws;
    float* ct = smf;
    __syncthreads();
    for (int i = tid; i < 4096; i += NTHREADS) ct[i] = cospif((float)i * (1.f / 2048.f));
    __syncthreads();
    bf16_t* F = (bf16_t*)(ws + WS_F);
    for (int k1 = bid; k1 < SEQ; k1 += G) {
#pragma unroll
        for (int hh = 0; hh < 2; ++hh) {
            const int c0 = hh * 4096 + tid * 8; float v[8];
#pragma unroll
            for (int e = 0; e < 8; ++e) { const int t = (c0 + e) & 4095; const int ph = (k1 * t) & 4095;
                v[e] = hh ? -ct[(ph - 1024) & 4095] * (1.f / 64.f) : ct[ph] * (1.f / 64.f); }
            u32x4 w; w.x = pk2(v[0], v[1]); w.y = pk2(v[2], v[3]); w.z = pk2(v[4], v[5]); w.w = pk2(v[6], v[7]);
            *(u32x4*)(F + (size_t)k1 * 8192 + c0) = w;
        }
    }
    bf16_t* FC = (bf16_t*)(ws + WS_FC);
    for (int k1 = bid; k1 < CTX; k1 += G) {
        const int t = tid & 255, ph = ((k1 * t) & 255) * 16;
        const float v = (tid < 256) ? ct[ph] * (1.f / 16.f) : -ct[(ph - 1024) & 4095] * (1.f / 16.f);
        FC[(size_t)k1 * 512 + tid] = (bf16_t)(pk2(v, 0.f) & 0xffffu);
    }
    __syncthreads();
}
__device__ __forceinline__ void phase_h0(cargs_t ap, int lane, int gw, int NGW) {
    unsigned char* ws = ap->ws;
    const float* x_in = ap->in[0]; const float* ctx_in = ap->in[2]; const float* norm_g = ap->in[6];
    const float* MOD = (const float*)(ws + WS_MOD); bf16_t* H = (bf16_t*)(ws + WS_H);
    for (int r = gw; r < MR; r += NGW) {
        const int id = (r < ML) ? (r >> 12) : 4;
        const float* xin = (r < ML) ? x_in + (size_t)r * DM : ctx_in + (size_t)(r - ML) * DM;
        const float* md = MOD + (size_t)id * (NMOD * DM);
        row_update(xin, nullptr, nullptr, nullptr, nullptr, norm_g, md, md + DM, H + (size_t)r * DM, lane);
    }
}
__device__ __forceinline__ void phase_inproj(cargs_t ap, LAS unsigned char* lds, int l, int G, int bid) {
    unsigned char* ws = ap->ws;
    pg8::Gemm g{(const bf16_t*)(ws + WS_H), (const bf16_t*)(ws + WS_WIN), MR, INW2, DM}; pg8::StaticOrder S; S.init(MR, INW2, G, bid);
    EpiInProj E{ws, (const float*)(ws + WS_TAB + TAB_LB) + l * 1024};
    pg8::gemm_phase<EpiInProj, pg8::StaticOrder, true, true>(lds, g, S, E);
}
__device__ __forceinline__ void attn_dispatch(cargs_t ap, LAS unsigned char* lds, int l, int u) {
    unsigned char* ws = ap->ws;
    const float lam = ((const float*)(ws + WS_TAB + TAB_LAM))[l];
    const float lam_init = 0.8f - 0.6f * expf(-0.3f * (float)l);
    const float* subln = ap->in[12] + l * 64;
    if (u < 256) attn_unit(ws, lds, u >> 6, (u >> 4) & 3, (u >> 6) * SEQ + (u & 15) * 256, 0, KEYS / 64, lam, 1.f - lam_init, subln);
    else { const int u2 = u - 256; attn_unit(ws, lds, u2 >> 2, u2 & 3, ML + (u2 >> 2) * CTX, SEQ, CTX / 64, lam, 1.f - lam_init, subln); }
}
constexpr int ATT_M1 = 192;
__device__ __forceinline__ void phase_m1(cargs_t ap, LAS unsigned char* lds, int l, int G, int bid) {
    unsigned char* ws = ap->ws;
    { pg8::Gemm g{(const bf16_t*)(ws + WS_F), (const bf16_t*)(ws + WS_BTL), SEQ, NB * 256, 2 * SEQ}; DftOrder S{G, bid, 0, 64, 16};
      EpiDft E{(bf16_t*)(ws + WS_H), 0}; pg8::gemm_phase<EpiDft, DftOrder, true, true>(lds, g, S, E); }
    { pg8::Gemm g{(const bf16_t*)(ws + WS_FC), (const bf16_t*)(ws + WS_BTC), CTX, NB * 256, 2 * CTX}; DftOrder S{G, bid, 64, 4, 1};
      EpiDft E{(bf16_t*)(ws + WS_H), 1}; pg8::gemm_phase<EpiDft, DftOrder, true, true>(lds, g, S, E); }
    if (bid >= 64) {
        for (int it = bid - 64; it < HG_ITEMS; it += G - 64) hg_pass1_item(ws, lds, it);
        for (int u = bid - 64; u < ATT_M1; u += G - 64) attn_dispatch(ap, lds, l, u);
    }
}
__device__ __forceinline__ void phase_m2(cargs_t ap, LAS unsigned char* lds, int l, int G, int bid) {
    if (bid < 32) hg_pass2_block(ap->ws, lds, bid >> 1, bid & 1);
    else for (int u = ATT_M1 + bid - 32; u < 272; u += G - 32) attn_dispatch(ap, lds, l, u);
}
__device__ __forceinline__ void phase_m3(cargs_t ap, int l, int lane, int gw, int NGW) {
    unsigned char* ws = ap->ws; const float* onorm = ap->in[10] + l * 128;
    for (int r = gw; r < MR; r += NGW) hg_combine_row(ws, r, onorm, lane);
}
__device__ __forceinline__ void phase_outproj(cargs_t ap, LAS unsigned char* lds, int G, int bid) {
    unsigned char* ws = ap->ws;
    pg8::Gemm g{(const bf16_t*)(ws + WS_H), (const bf16_t*)(ws + WS_WOUT), MR, DM, DM}; pg8::StaticOrder S; S.init(MR, DM, G, bid);
    EpiF32 E{(float*)(ws + WS_Y), DM}; pg8::gemm_phase<EpiF32, pg8::StaticOrder, true, true>(lds, g, S, E);
}
__device__ __forceinline__ void phase_r1(cargs_t ap, int l, int lane, int gw, int NGW) {
    unsigned char* ws = ap->ws;
    const float* x_in = ap->in[0]; const float* ctx_in = ap->in[2]; const float* norm_g = ap->in[6]; float* out = ap->out;
    const float* MOD = (const float*)(ws + WS_MOD); bf16_t* H = (bf16_t*)(ws + WS_H); float* XC = (float*)(ws + WS_XC); const float* Y = (const float*)(ws + WS_Y);
    const float* ng = norm_g + (size_t)l * 4 * DM;
    for (int r = gw; r < MR; r += NGW) {
        const int id = (r < ML) ? (r >> 12) : 4;
        const float* md = MOD + ((size_t)l * 5 + id) * (NMOD * DM);
        const float* xin; float* xout;
        if (r < ML) { xout = out + (size_t)r * DM; xin = (l == 0) ? x_in + (size_t)r * DM : xout; }
        else { xout = XC + (size_t)(r - ML) * DM; xin = (l == 0) ? ctx_in + (size_t)(r - ML) * DM : xout; }
        row_update(xin, Y + (size_t)r * DM, md + 2 * DM, ng + DM, xout, ng + 2 * DM, md + 3 * DM, md + 4 * DM, H + (size_t)r * DM, lane);
    }
}
__device__ __forceinline__ void phase_ffnin(cargs_t ap, LAS unsigned char* lds, int G, int bid) {
    unsigned char* ws = ap->ws;
    pg8::Gemm g{(const bf16_t*)(ws + WS_H), (const bf16_t*)(ws + WS_WFI), MR, 2 * FFH, DM}; pg8::StaticOrder S; S.init(MR, 2 * FFH, G, bid);
    EpiSwiGLU E{(bf16_t*)(ws + WS_ACT)}; pg8::gemm_phase<EpiSwiGLU, pg8::StaticOrder, true, true>(lds, g, S, E);
}
__device__ __forceinline__ void phase_ffnout(cargs_t ap, LAS unsigned char* lds, int G, int bid) {
    unsigned char* ws = ap->ws;
    pg8::Gemm g{(const bf16_t*)(ws + WS_ACT), (const bf16_t*)(ws + WS_WFO), MR, DM, FFH}; pg8::StaticOrder S; S.init(MR, DM, G, bid);
    EpiF32 E{(float*)(ws + WS_Y), DM}; pg8::gemm_phase<EpiF32, pg8::StaticOrder, true, true>(lds, g, S, E);
}
__device__ __forceinline__ void phase_r2(cargs_t ap, int l, int lane, int gw, int NGW) {
    unsigned char* ws = ap->ws;
    const float* norm_g = ap->in[6]; float* out = ap->out;
    const float* MOD = (const float*)(ws + WS_MOD); bf16_t* H = (bf16_t*)(ws + WS_H); float* XC = (float*)(ws + WS_XC); const float* Y = (const float*)(ws + WS_Y);
    const bool more = (l + 1 < DEPTH);
    const float* ng = norm_g + (size_t)l * 4 * DM;
    const float* ng2 = norm_g + (size_t)(more ? l + 1 : l) * 4 * DM;
    for (int r = gw; r < MR; r += NGW) {
        const int id = (r < ML) ? (r >> 12) : 4;
        const float* md = MOD + ((size_t)l * 5 + id) * (NMOD * DM);
        float* xs = (r < ML) ? out + (size_t)r * DM : XC + (size_t)(r - ML) * DM;
        const float* md2 = MOD + ((size_t)(more ? l + 1 : l) * 5 + id) * (NMOD * DM);
        row_update(xs, Y + (size_t)r * DM, md + 5 * DM, ng + 3 * DM, xs, ng2, md2, md2 + DM, more ? H + (size_t)r * DM : nullptr, lane);
    }
}
__device__ __forceinline__ void phase_weights(cargs_t ap, LAS unsigned char* lds, int layer, int wave, int lane, int gw, int NGW) {
    const float* in4[4] = {ap->in[7], ap->in[8], ap->in[13], ap->in[14]};
    convert_weights(in4, ap->ws, layer, lds, wave, lane, gw, NGW);
}

__global__ void __launch_bounds__(NTHREADS, 2) fwd_kernel(Args args) {
    extern __shared__ __attribute__((aligned(16))) unsigned char lds_raw[];
    LAS unsigned char* lds = (LAS unsigned char*)lds_raw;
    volatile LAS unsigned* MISC = (volatile LAS unsigned*)(lds + MISC_OFF);
    const int G = gridDim.x, bid = blockIdx.x, NGW = G * 8;
#define TID (opaque_tid())
#define LANE (opaque_tid() & 63)
#define WAVE (__builtin_amdgcn_readfirstlane(opaque_tid() >> 6))
#define GW (bid * 8 + WAVE)
    const int lo = args.ph_lo, hi = args.ph_hi;
    const bool single = (lo == 0 && hi == NPHASE);
    for (int u = threadIdx.x; u < (LDS_BYTES - LDSCTL_OFF) / 4; u += NTHREADS) ((LAS unsigned*)(lds + LDSCTL_OFF))[u] = 0u;
    __syncthreads();
    XcdBarrier bar; bar.bar = (unsigned*)(args.ws + WS_CTL) + CW_BAR; bar.x = 0; bar.st = nullptr;
    if (single) bar = xcd_barrier_post((unsigned*)(args.ws + WS_CTL) + CW_BAR, MISC + 8);
    bool first_sync = true;
    float* smf = (float*)lds_raw;
#define IN(k) (lo <= (k) && (k) < hi)
#define SEAM(k) do { if (IN(k) && IN((k) + 1)) { if (first_sync) { __threadfence(); cg::this_grid().sync(); first_sync = false; } else xcd_barrier(bar); } } while (0)

    if (IN(0)) {
        if (bid == 0) phase_tables(get_args(), TID);
        phase_mod(get_args(), smf, TID, bid, G);
        phase_dftmat(get_args(), smf, TID, bid, G);
        phase_weights(get_args(), lds, 0, WAVE, LANE, GW, NGW);
    }
    SEAM(0);
    if (IN(1)) phase_h0(get_args(), LANE, GW, NGW);
    SEAM(1);
#pragma nounroll
    for (int l = 0; l < DEPTH; ++l) {
        const int pb = 2 + PPL * l;
        if (IN(pb + 0)) phase_inproj(get_args(), lds, l, G, bid);
        SEAM(pb + 0);
        if (IN(pb + 1)) phase_m1(get_args(), lds, l, G, bid);
        SEAM(pb + 1);
        if (IN(pb + 2)) phase_m2(get_args(), lds, l, G, bid);
        SEAM(pb + 2);
        if (IN(pb + 3)) phase_m3(get_args(), l, LANE, GW, NGW);
        SEAM(pb + 3);
        if (IN(pb + 4)) phase_outproj(get_args(), lds, G, bid);
        SEAM(pb + 4);
        if (IN(pb + 5)) phase_r1(get_args(), l, LANE, GW, NGW);
        SEAM(pb + 5);
        if (IN(pb + 6)) phase_ffnin(get_args(), lds, G, bid);
        SEAM(pb + 6);
        if (IN(pb + 7)) phase_ffnout(get_args(), lds, G, bid);
        SEAM(pb + 7);
        if (IN(pb + 8)) {
            phase_r2(get_args(), l, LANE, GW, NGW);
            if (l + 1 < DEPTH) phase_weights(get_args(), lds, l + 1, WAVE, LANE, GW, NGW);
        }
        SEAM(pb + 8);
    }
#undef IN
#undef SEAM
}

#ifndef N_LAUNCH_MODE
#define N_LAUNCH_MODE 1
#endif
extern "C" void kernel_launch(void* const* d_in, const int* in_sizes, int n_in, void* d_out, int out_size, void* d_ws, size_t ws_size, hipStream_t stream) {
    static int grid = 0;
    if (grid == 0) {
        int dev = 0, cus = 0, per_cu = 0;
        hipGetDevice(&dev);
        hipDeviceGetAttribute(&cus, hipDeviceAttributeMultiprocessorCount, dev);
        hipFuncSetAttribute((const void*)fwd_kernel, hipFuncAttributeMaxDynamicSharedMemorySize, LDS_BYTES);
        hipOccupancyMaxActiveBlocksPerMultiprocessor(&per_cu, (const void*)fwd_kernel, NTHREADS, LDS_BYTES);
        (void)hipGetLastError();
        if (per_cu < 1) { fprintf(stderr, "kernel_launch: occupancy query says %d blocks per CU\n", per_cu); per_cu = 1; }
        grid = cus;
        if (ws_size < WS_END || ws_size < WS_ACT + (size_t)MR * FFH * 2) fprintf(stderr, "kernel_launch: workspace too small: %zu\n", ws_size);
    }
    hipMemsetAsync((char*)d_ws + WS_CTL, 0, CTL_ZERO_BYTES, stream);
    Args a; memset(&a, 0, sizeof(a));
    for (int i = 0; i < 15; ++i) a.in[i] = (const float*)d_in[i];
    a.out = (float*)d_out; a.ws = (unsigned char*)d_ws;
#if N_LAUNCH_MODE == 1
    a.ph_lo = 0; a.ph_hi = NPHASE;
    void* kargs[] = {&a};
    hipError_t e = hipLaunchCooperativeKernel((const void*)fwd_kernel, dim3(grid), dim3(NTHREADS), kargs, LDS_BYTES, stream);
    if (e != hipSuccess) fprintf(stderr, "cooperative launch failed: %s (grid %d)\n", hipGetErrorString(e), grid);
#else
    for (int p = 0; p < NPHASE; ++p) { a.ph_lo = p; a.ph_hi = p + 1; hipLaunchKernelGGL(fwd_kernel, dim3(grid), dim3(NTHREADS), LDS_BYTES, stream, a); }
#endif
}
```
